# Optimizing an MI355X kernel written in HIP

```python
import jax
import jax.numpy as jnp
from jax import lax
import numpy as np

D_MODEL = 1024
BATCH = 8
SEQ = 4096
DEPTH = 2

HEAD_DIM = 64
ROPE_DIM = HEAD_DIM // 4
ROPE_THETA = 500000.0
Q_BLOCK = 128
NEG_INF = -1e30
RMS_EPS = 1e-6

NSA_HEADS = 4
NSA_CMP_LEN = 32
NSA_CMP_STRIDE = 16
NSA_CMP_HIDDEN = 128
NSA_SEL_LEN = 64
NSA_SEL_TOPK = 16
NSA_WINDOW = 512
NSA_FORCE_SCORE = 1e4

DIL_PATTERNS = ((128, 1), (512, 4), (2048, 16))
DIL_HEADS_PER_GROUP = 2
DIL_HEADS = DIL_HEADS_PER_GROUP * len(DIL_PATTERNS)

FOX_HEADS = 6

D_FF = 2816

NSA_Q_W = NSA_HEADS * HEAD_DIM
NSA_KV_W = 6 * HEAD_DIM
NSA_GATE_W = 3 * NSA_HEADS
DIL_W = DIL_HEADS * HEAD_DIM
DIL_OUT_W = DIL_HEADS_PER_GROUP * HEAD_DIM
FOX_W = FOX_HEADS * HEAD_DIM
IN_WIDTHS = (NSA_Q_W, NSA_KV_W, NSA_GATE_W, 3 * DIL_W, 3 * FOX_W, FOX_HEADS, 3 * D_MODEL)
IN_COLS = sum(IN_WIDTHS)

kernel_name = 'hybrid_nsa_dilated_fox_macaron_block'


def _split_cols(x, widths):
    offsets = [int(o) for o in np.cumsum(widths)[:-1]]
    return jnp.split(x, offsets, axis=-1)


def _rms_norm(x, g):
    xf = x.astype(jnp.float32)
    y = xf * lax.rsqrt(jnp.mean(xf * xf, axis=-1, keepdims=True) + RMS_EPS)
    return (y * g.astype(jnp.float32)).astype(x.dtype)


def _modulate(x, shift, scale):
    return x * (1.0 + scale) + shift


def _swiglu(x, w_in, w_out):
    gate, up = jnp.split(x @ w_in, 2, axis=-1)
    return (jax.nn.silu(gate) * up) @ w_out


def _rope_tables(seq_len):
    inv_freq = ROPE_THETA ** (-jnp.arange(0, ROPE_DIM, 2, dtype=jnp.float32) / ROPE_DIM)
    ang = jnp.arange(seq_len, dtype=jnp.float32)[:, None] * inv_freq[None, :]
    return jnp.cos(ang), jnp.sin(ang)


def _partial_rope(x, cos, sin):
    half = ROPE_DIM // 2
    c = cos[None, :, None, :]
    s = sin[None, :, None, :]
    x1 = x[..., :half].astype(jnp.float32)
    x2 = x[..., half:ROPE_DIM].astype(jnp.float32)
    rot = jnp.concatenate([x1 * c - x2 * s, x2 * c + x1 * s], axis=-1).astype(x.dtype)
    return jnp.concatenate([rot, x[..., ROPE_DIM:]], axis=-1)


def _masked_softmax(s, mask):
    s = jnp.where(mask, s, NEG_INF)
    m = jnp.max(s, axis=-1, keepdims=True)
    e = jnp.where(mask, jnp.exp(s - m), 0.0)
    den = jnp.sum(e, axis=-1, keepdims=True)
    den = jnp.where(den > 0, den, 1.0)
    return e / den, m + jnp.log(den)


def _nsa_attention(q, k_cmp, v_cmp, k_sel, v_sel, k_win, v_win, gate_logits,
                   cmp_pe, cmp_w1, cmp_w2):
    B, S = q.shape[0], q.shape[1]
    scale = HEAD_DIM ** -0.5
    n_cmp = (S - NSA_CMP_LEN) // NSA_CMP_STRIDE + 1
    cmp_start = np.arange(n_cmp) * NSA_CMP_STRIDE
    cmp_idx = cmp_start[:, None] + np.arange(NSA_CMP_LEN)[None, :]

    def compress(t, j):
        blk = t[:, cmp_idx] + cmp_pe[j]
        hid = jax.nn.silu(blk.reshape(B, n_cmp, NSA_CMP_LEN * HEAD_DIM) @ cmp_w1[j])
        return hid @ cmp_w2[j]

    kc = compress(k_cmp, 0)
    vc = compress(v_cmp, 1)
    cmp_end = jnp.asarray(cmp_start + NSA_CMP_LEN - 1)
    n_sel = S // NSA_SEL_LEN
    sel_start = np.arange(n_sel) * NSA_SEL_LEN
    ov = np.minimum(cmp_start[:, None] + NSA_CMP_LEN, sel_start[None, :] + NSA_SEL_LEN) \
        - np.maximum(cmp_start[:, None], sel_start[None, :])
    overlap = jnp.asarray(np.clip(ov, 0, None) / NSA_CMP_LEN, dtype=jnp.float32)
    top_k = min(NSA_SEL_TOPK, n_sel)
    sel_ids = jnp.arange(n_sel)
    kw_pad = jnp.pad(k_win, ((0, 0), (NSA_WINDOW, 0), (0, 0)))
    vw_pad = jnp.pad(v_win, ((0, 0), (NSA_WINDOW, 0), (0, 0)))
    win_len = NSA_WINDOW + Q_BLOCK
    gather = jax.vmap(lambda a, i: a[i])

    def block(qb):
        q0 = qb * Q_BLOCK
        t = q0 + jnp.arange(Q_BLOCK)
        qblk = lax.dynamic_slice_in_dim(q, q0, Q_BLOCK, axis=1)
        s = jnp.einsum('bqhd,bnd->bhqn', qblk, kc).astype(jnp.float32) * scale
        p_cmp, _ = _masked_softmax(s, cmp_end[None, :] <= t[:, None])
        o_cmp = jnp.einsum('bhqn,bnd->bqhd', p_cmp.astype(vc.dtype), vc)
        imp = jnp.einsum('bhqn,nj->bqj', p_cmp, overlap)
        valid = (sel_ids[None, :] * NSA_SEL_LEN) <= t[:, None]
        forced = (sel_ids[None, :] == (t // NSA_SEL_LEN)[:, None]) | (sel_ids[None, :] == 0)
        imp = jnp.where(forced, NSA_FORCE_SCORE, jnp.where(valid, imp, -1.0))
        _, blk_idx = lax.top_k(imp, top_k)
        tok = (blk_idx[..., None] * NSA_SEL_LEN + jnp.arange(NSA_SEL_LEN)).reshape(B, Q_BLOCK * top_k * NSA_SEL_LEN)
        ks = gather(k_sel, tok).reshape(B, Q_BLOCK, top_k * NSA_SEL_LEN, HEAD_DIM)
        vs = gather(v_sel, tok).reshape(B, Q_BLOCK, top_k * NSA_SEL_LEN, HEAD_DIM)
        s = jnp.einsum('bqhd,bqkd->bhqk', qblk, ks).astype(jnp.float32) * scale
        smask = (tok.reshape(B, Q_BLOCK, top_k * NSA_SEL_LEN) <= t[None, :, None])[:, None]
        p, _ = _masked_softmax(s, smask)
        o_sel = jnp.einsum('bhqk,bqkd->bqhd', p.astype(vs.dtype), vs)
        kw = lax.dynamic_slice_in_dim(kw_pad, q0, win_len, axis=1)
        vw = lax.dynamic_slice_in_dim(vw_pad, q0, win_len, axis=1)
        kpos = q0 - NSA_WINDOW + jnp.arange(win_len)
        wmask = (kpos[None, :] <= t[:, None]) & (kpos[None, :] > t[:, None] - NSA_WINDOW) & (kpos[None, :] >= 0)
        s = jnp.einsum('bqhd,bkd->bhqk', qblk, kw).astype(jnp.float32) * scale
        p, _ = _masked_softmax(s, wmask)
        o_win = jnp.einsum('bhqk,bkd->bqhd', p.astype(vw.dtype), vw)
        g = jax.nn.sigmoid(lax.dynamic_slice_in_dim(gate_logits, q0, Q_BLOCK, axis=1).astype(jnp.float32)).astype(q.dtype)
        return g[..., 0:1] * o_cmp + g[..., 1:2] * o_sel + g[..., 2:3] * o_win

    out = lax.map(block, jnp.arange(S // Q_BLOCK))
    return out.transpose(1, 0, 2, 3, 4).reshape(B, S, NSA_Q_W)


def _dilated_attention(q, k, v):
    B, S = q.shape[0], q.shape[1]
    scale = HEAD_DIM ** -0.5
    hpg = DIL_HEADS_PER_GROUP
    qg_all = [q[:, :, g * hpg:(g + 1) * hpg] for g in range(len(DIL_PATTERNS))]
    kg_all = [k[:, :, g * hpg:(g + 1) * hpg] for g in range(len(DIL_PATTERNS))]
    vg_all = [v[:, :, g * hpg:(g + 1) * hpg] for g in range(len(DIL_PATTERNS))]

    def block(qb):
        q0 = qb * Q_BLOCK
        t = q0 + jnp.arange(Q_BLOCK)
        outs, lses = [], []
        for g, (window, dil) in enumerate(DIL_PATTERNS):
            qg = lax.dynamic_slice_in_dim(qg_all[g], q0, Q_BLOCK, axis=1)
            pos = t[:, None] - dil * jnp.arange(window // dil + 1)[None, :]
            valid = pos >= 0
            idx = jnp.maximum(pos, 0)
            kk = kg_all[g][:, idx]
            vv = vg_all[g][:, idx]
            s = jnp.einsum('bqhd,bqkhd->bhqk', qg, kk).astype(jnp.float32) * scale
            p, lse = _masked_softmax(s, valid)
            outs.append(jnp.einsum('bhqk,bqkhd->bqhd', p.astype(vv.dtype), vv))
            lses.append(lse[..., 0])
        wts = jax.nn.softmax(jnp.stack(lses, axis=0), axis=0)
        wts = wts.transpose(0, 1, 3, 2)[..., None].astype(q.dtype)
        return jnp.sum(wts * jnp.stack(outs, axis=0), axis=0)

    out = lax.map(block, jnp.arange(S // Q_BLOCK))
    return out.transpose(1, 0, 2, 3, 4).reshape(B, S, DIL_OUT_W)


def _forgetting_attention(q, k, v, f_logit, f_bias):
    B, S = q.shape[0], q.shape[1]
    scale = HEAD_DIM ** -0.5
    log_f = jax.nn.log_sigmoid(f_logit.astype(jnp.float32) + f_bias.astype(jnp.float32))
    cum = jnp.cumsum(log_f, axis=1)
    cum_k = cum.transpose(0, 2, 1)[:, :, None, :]
    kpos = jnp.arange(S)

    def block(qb):
        q0 = qb * Q_BLOCK
        t = q0 + jnp.arange(Q_BLOCK)
        qblk = lax.dynamic_slice_in_dim(q, q0, Q_BLOCK, axis=1)
        cq = lax.dynamic_slice_in_dim(cum, q0, Q_BLOCK, axis=1).transpose(0, 2, 1)[..., None]
        s = jnp.einsum('bqhd,bkhd->bhqk', qblk, k).astype(jnp.float32) * scale + (cq - cum_k)
        p, _ = _masked_softmax(s, kpos[None, :] <= t[:, None])
        return jnp.einsum('bhqk,bkhd->bqhd', p.astype(v.dtype), v)

    out = lax.map(block, jnp.arange(S // Q_BLOCK))
    return out.transpose(1, 0, 2, 3, 4).reshape(B, S, FOX_W)


def _token_mixing(n, w_in, cmp_pe, cmp_w1, cmp_w2, fox_bias, br_nsa, br_dil, br_fox, w_out, cos, sin):
    B, S = n.shape[0], n.shape[1]
    proj = n @ w_in
    nsa_q, nsa_kv, nsa_g, dil_qkv, fox_qkv, fox_f, merge_g = _split_cols(proj, IN_WIDTHS)

    def heads(t, h):
        return t.reshape(B, S, h, HEAD_DIM)

    def rope_single(t):
        return _partial_rope(t[:, :, None, :], cos, sin)[:, :, 0, :]

    q_a = _partial_rope(heads(nsa_q, NSA_HEADS), cos, sin)
    kc, vc, ks, vs, kw, vw = jnp.split(nsa_kv, 6, axis=-1)
    y_a = _nsa_attention(q_a, rope_single(kc), vc, rope_single(ks), vs, rope_single(kw), vw,
                         nsa_g.reshape(B, S, NSA_HEADS, 3), cmp_pe, cmp_w1, cmp_w2)
    dq, dk, dv = jnp.split(dil_qkv, 3, axis=-1)
    y_b = _dilated_attention(_partial_rope(heads(dq, DIL_HEADS), cos, sin),
                             _partial_rope(heads(dk, DIL_HEADS), cos, sin),
                             heads(dv, DIL_HEADS))
    fq, fk, fv = jnp.split(fox_qkv, 3, axis=-1)
    y_c = _forgetting_attention(heads(fq, FOX_HEADS), heads(fk, FOX_HEADS), heads(fv, FOX_HEADS),
                                fox_f, fox_bias)
    g_a, g_b, g_c = jnp.split(jax.nn.sigmoid(merge_g), 3, axis=-1)
    merged = g_a * (y_a @ br_nsa) + g_b * (y_b @ br_dil) + g_c * (y_c @ br_fox)
    return merged @ w_out


def setup_inputs(seed: int = 0) -> dict:
    key = jax.random.key(seed)
    ks = jax.random.split(key, 17)
    L, D = DEPTH, D_MODEL

    def nrm(k, shape, scale):
        return jax.random.normal(k, shape, jnp.float32) * scale

    return {
        'x': nrm(ks[0], (BATCH, SEQ, D), 1.0),
        'c': nrm(ks[1], (BATCH, D), 1.0),
        'ada_w': nrm(ks[2], (L, D, 9 * D), 0.5 * D ** -0.5),
        'ada_b': nrm(ks[3], (L, 9 * D), 0.02),
        'norm_g': 1.0 + nrm(ks[4], (L, 3, D), 0.05),
        'final_norm_g': 1.0 + nrm(ks[5], (D,), 0.05),
        'ffn_w_in': nrm(ks[6], (L, 2, D, 2 * D_FF), D ** -0.5),
        'ffn_w_out': nrm(ks[7], (L, 2, D_FF, D), D_FF ** -0.5),
        'mix_w_in': nrm(ks[8], (L, D, IN_COLS), D ** -0.5),
        'nsa_cmp_pe': nrm(ks[9], (L, 2, NSA_CMP_LEN, HEAD_DIM), 0.1),
        'nsa_cmp_w1': nrm(ks[10], (L, 2, NSA_CMP_LEN * HEAD_DIM, NSA_CMP_HIDDEN), (NSA_CMP_LEN * HEAD_DIM) ** -0.5),
        'nsa_cmp_w2': nrm(ks[11], (L, 2, NSA_CMP_HIDDEN, HEAD_DIM), NSA_CMP_HIDDEN ** -0.5),
        'fox_f_bias': jax.random.uniform(ks[12], (L, FOX_HEADS), jnp.float32, 1.0, 6.0),
        'br_w_nsa': nrm(ks[13], (L, NSA_Q_W, D), NSA_Q_W ** -0.5),
        'br_w_dil': nrm(ks[14], (L, DIL_OUT_W, D), DIL_OUT_W ** -0.5),
        'br_w_fox': nrm(ks[15], (L, FOX_W, D), FOX_W ** -0.5),
        'mix_w_out': nrm(ks[16], (L, D, D), D ** -0.5),
    }


def reference(x, c, ada_w, ada_b, norm_g, final_norm_g, ffn_w_in, ffn_w_out, mix_w_in,
              nsa_cmp_pe, nsa_cmp_w1, nsa_cmp_w2, fox_f_bias, br_w_nsa, br_w_dil, br_w_fox,
              mix_w_out):
    S = x.shape[1]
    cos, sin = _rope_tables(S)
    cond = jax.nn.silu(c)
    h = x
    for l in range(DEPTH):
        mod = cond @ ada_w[l] + ada_b[l]
        sh1, sc1, ga1, sh2, sc2, ga2, sh3, sc3, ga3 = [m[:, None, :] for m in jnp.split(mod, 9, axis=-1)]
        n = _modulate(_rms_norm(h, norm_g[l, 0]), sh1, sc1)
        h = h + 0.5 * ga1 * _swiglu(n, ffn_w_in[l, 0], ffn_w_out[l, 0])
        n = _modulate(_rms_norm(h, norm_g[l, 1]), sh2, sc2)
        h = h + ga2 * _token_mixing(n, mix_w_in[l], nsa_cmp_pe[l], nsa_cmp_w1[l], nsa_cmp_w2[l],
                                    fox_f_bias[l], br_w_nsa[l], br_w_dil[l], br_w_fox[l],
                                    mix_w_out[l], cos, sin)
        n = _modulate(_rms_norm(h, norm_g[l, 2]), sh3, sc3)
        h = h + 0.5 * ga3 * _swiglu(n, ffn_w_in[l, 1], ffn_w_out[l, 1])
    return _rms_norm(h, final_norm_g)
```

```cpp
#include <hip/hip_runtime.h>
#include <hip/hip_cooperative_groups.h>
#include <cstdio>
namespace cg = cooperative_groups;

typedef unsigned short u16;
typedef unsigned long long u64;
typedef __attribute__((ext_vector_type(8))) short bf16x8;
typedef __attribute__((ext_vector_type(4))) short bf16x4;
typedef __attribute__((ext_vector_type(16))) float f32x16;
typedef __attribute__((ext_vector_type(2))) __bf16 bf2_t;
typedef __attribute__((ext_vector_type(2))) float f2_t;
typedef __attribute__((ext_vector_type(4))) unsigned u32x4;
typedef __attribute__((ext_vector_type(2))) unsigned u32x2;
typedef __attribute__((ext_vector_type(4))) float f32x4;
#define DI __device__ __forceinline__

constexpr int S = 4096, NB = 8, T = NB * S, DM = 1024, DFF = 2816;
constexpr float LOG2E = 1.4426950408889634f;
constexpr float SC2 = 0.125f * LOG2E;

constexpr size_t SZ_WFFN_IN = (size_t)5632 * 1024 * 2;
constexpr size_t SZ_WFFN_OUT = (size_t)1024 * 2816 * 2;
constexpr size_t SZ_WMIX = (size_t)6144 * 1024 * 2;
constexpr size_t OFF_WFFN_IN = 0;
constexpr size_t OFF_WFFN_OUT = OFF_WFFN_IN + 4 * SZ_WFFN_IN;
constexpr size_t OFF_WMIX = OFF_WFFN_OUT + 4 * SZ_WFFN_OUT;
constexpr size_t OFF_WBRA = OFF_WMIX + 2 * SZ_WMIX;
constexpr size_t OFF_WBRB = OFF_WBRA + 2 * 1024 * 256 * 2;
constexpr size_t OFF_WBRC = OFF_WBRB + 2 * 1024 * 128 * 2;
constexpr size_t OFF_WOUT = OFF_WBRC + 2 * 1024 * 384 * 2;
constexpr size_t OFF_WC1 = OFF_WOUT + 2 * 1024 * 1024 * 2;
constexpr size_t OFF_WC2 = OFF_WC1 + 4 * 128 * 2048 * 2;
constexpr size_t OFF_PEB = OFF_WC2 + 4 * 128 * 128 * 2;
constexpr size_t OFF_MOD = OFF_PEB + 4 * 128 * 4;
constexpr size_t SZ_MOD = (size_t)2 * 8 * 9216 * 4;
constexpr size_t OFF_MODPART = OFF_MOD + SZ_MOD;
constexpr size_t OFF_ROPE = OFF_MODPART + 16 * SZ_MOD;
constexpr size_t OFF_CTR = OFF_ROPE + (size_t)S * 16 * 4;
constexpr size_t OFF_XBAR = OFF_CTR + 256;
constexpr size_t OFF_NBUF = OFF_XBAR + 16384;
constexpr size_t OFF_ARENA = OFF_NBUF + (size_t)T * 1024 * 2;
constexpr size_t A_QNSA = OFF_ARENA;
constexpr size_t A_KCMP = A_QNSA + (size_t)T * 256 * 2;
constexpr size_t A_VCMP = A_KCMP + (size_t)T * 64 * 2 + 4096;
constexpr size_t A_KSEL = A_VCMP + (size_t)T * 64 * 2 + 4096;
constexpr size_t A_VSELT = A_KSEL + (size_t)T * 64 * 2;
constexpr size_t A_KWIN = A_VSELT + (size_t)T * 64 * 2;
constexpr size_t A_VWINT = A_KWIN + (size_t)T * 64 * 2;
constexpr size_t A_DQ = A_VWINT + (size_t)T * 64 * 2;
constexpr size_t A_DK = A_DQ + (size_t)T * 384 * 2;
constexpr size_t A_DVT = A_DK + (size_t)T * 384 * 2;
constexpr size_t A_FQ = A_DVT + (size_t)T * 384 * 2;
constexpr size_t A_FK = A_FQ + (size_t)T * 384 * 2;
constexpr size_t A_FVT = A_FK + (size_t)T * 384 * 2;
constexpr size_t A_GNSA = A_FVT + (size_t)T * 384 * 2;
constexpr size_t A_FLOG = A_GNSA + (size_t)T * 12 * 4;
constexpr size_t A_CUM = A_FLOG + (size_t)T * 6 * 4;
constexpr size_t A_KC = A_CUM + (size_t)T * 6 * 4;
constexpr size_t A_VCT = A_KC + (size_t)NB * 256 * 64 * 2;
constexpr size_t A_HIDC = A_VCT + (size_t)NB * 256 * 64 * 2;
constexpr size_t A_YA = A_HIDC + (size_t)NB * 2 * 256 * 128 * 2;
constexpr size_t A_YB = A_YA + (size_t)T * 256 * 2;
constexpr size_t A_YC = A_YB + (size_t)T * 128 * 2;
constexpr size_t A_DILP = A_YC + (size_t)T * 384 * 2;
constexpr size_t A_DILL = A_DILP + (size_t)3 * T * 128 * 4;
constexpr size_t A_END = A_DILL + (size_t)3 * T * 2 * 4;
constexpr size_t A_HID = OFF_ARENA;
constexpr size_t A_MERGED = OFF_ARENA;
static_assert(A_END <= (size_t)512 * 1024 * 1024, "workspace overflow");
static_assert(A_MERGED + (size_t)T * 1024 * 2 <= A_GNSA, "merged aliases live data");

struct Params {
  const float *x, *c, *ada_w, *ada_b, *norm_g, *final_g, *ffn_w_in, *ffn_w_out, *mix_w_in, *cmp_pe, *cmp_w1,
      *cmp_w2, *fox_bias, *br_nsa, *br_dil, *br_fox, *mix_w_out;
  float* out;
  char* ws;
};

DI unsigned pack2(float lo, float hi) {
  f2_t v = {lo, hi};
  bf2_t r = __builtin_convertvector(v, bf2_t);
  return __builtin_bit_cast(unsigned, r);
}
DI u16 f2bf(float f) { return (u16)(pack2(f, 0.f) & 0xffffu); }
DI float sigmoidf_(float x) { return __builtin_amdgcn_rcpf(1.f + __expf(-x)); }
DI float siluf_(float x) { return x * sigmoidf_(x); }
DI int launder_i(int v) { asm volatile("" : "+v"(v)); return v; }
DI int crow(int i, int h) { return (i & 3) + 8 * (i >> 2) + 4 * h; }
DI f32x16 mfma32(bf16x8 a, bf16x8 b, f32x16 c) { return __builtin_amdgcn_mfma_f32_32x32x16_bf16(a, b, c, 0, 0, 0); }
DI f32x16 zero16() { f32x16 z; for (int i = 0; i < 16; ++i) z[i] = 0.f; return z; }

template <int MI, int NI>
DI void g_issue(const u16* A, long lda, const u16* B, long ldb, int k0, char* sA, char* sB, int tid) {
  const unsigned r0 = tid >> 3;
  const unsigned ch = (((tid & 7) ^ ((r0 >> 1) & 7)) * 8) + k0;
  const unsigned la = (unsigned)lda, lb = (unsigned)ldb;
  const int wave = tid >> 6;
#pragma unroll
  for (int i = 0; i < MI; ++i)
    __builtin_amdgcn_global_load_lds((const unsigned*)(A + ((r0 + 64 * i) * la + ch)), (unsigned*)(sA + wave * 1024 + i * 8192), 16, 0, 0);
#pragma unroll
  for (int i = 0; i < 2 * NI; ++i)
    __builtin_amdgcn_global_load_lds((const unsigned*)(B + ((r0 + 64 * i) * lb + ch)), (unsigned*)(sB + wave * 1024 + i * 8192), 16, 0, 0);
}
template <int MI, int NI>
DI void g_frag(bf16x8 (&a)[MI], bf16x8 (&b)[NI], int j, const char* sA, const char* sB, int arow, int brow, int co) {
  if (j < NI) b[j] = *(const bf16x8*)(sB + (brow + j * 32) * 128 + co);
  else a[j - NI] = *(const bf16x8*)(sA + (arow + (j - NI) * 32) * 128 + co);
}
template <int MI, int NI, bool SW = false>
DI void g_step(f32x16 (&acc)[MI][NI], const char* sA, const char* sB, int arow, int brow, int co) {
  bf16x8 a1[MI], b1[NI];
#pragma unroll
  for (int j = 0; j < MI + NI; ++j) g_frag<MI, NI>(a1, b1, j, sA, sB, arow, brow, co);
#pragma unroll
  for (int mi = 0; mi < MI; ++mi)
#pragma unroll
    for (int ni = 0; ni < NI; ++ni) acc[mi][ni] = SW ? mfma32(b1[ni], a1[mi], acc[mi][ni]) : mfma32(a1[mi], b1[ni], acc[mi][ni]);
}
template <int MI, int NI, bool DB>
DI void g_compute(f32x16 (&acc)[MI][NI], const char* sA, const char* sB, int wm, int wn, int lane) {
  const int r = lane & 31, h = lane >> 5;
  const int swz = (r >> 1) & 7;
  const int arow = wm * 32 * MI + r, brow = wn * 32 * NI + r;
  if (!DB) {
#pragma unroll
    for (int s = 0; s < 4; ++s) {
      bf16x8 a1[MI], b1[NI];
      const int co1 = (((2 * s + h) ^ swz) << 4);
#pragma unroll
      for (int j = 0; j < MI + NI; ++j) g_frag<MI, NI>(a1, b1, j, sA, sB, arow, brow, co1);
#pragma unroll
      for (int mi = 0; mi < MI; ++mi)
#pragma unroll
        for (int ni = 0; ni < NI; ++ni) acc[mi][ni] = mfma32(a1[mi], b1[ni], acc[mi][ni]);
    }
    return;
  }
  bf16x8 a[2][MI], b[2][NI];
#pragma unroll
  for (int j = 0; j < MI + NI; ++j) g_frag<MI, NI>(a[0], b[0], j, sA, sB, arow, brow, ((h ^ swz) << 4));
#pragma unroll
  for (int s = 0; s < 4; ++s) {
    const int cur = s & 1, nx = cur ^ 1;
    const int co = (((2 * (s + 1) + h) ^ swz) << 4);
#pragma unroll
    for (int mi = 0; mi < MI; ++mi)
#pragma unroll
      for (int ni = 0; ni < NI; ++ni) {
        acc[mi][ni] = mfma32(a[cur][mi], b[cur][ni], acc[mi][ni]);
        const int j = mi * NI + ni;
        if (s < 3 && j < MI + NI) g_frag<MI, NI>(a[nx], b[nx], j, sA, sB, arow, brow, co);
      }
    if (s < 3) {
#pragma unroll
      for (int j = MI * NI; j < MI + NI; ++j) g_frag<MI, NI>(a[nx], b[nx], j, sA, sB, arow, brow, co);
    }
    if (s < 3) {
#pragma unroll
      for (int j = 0; j < MI + NI && j < MI * NI; ++j) {
        __builtin_amdgcn_sched_group_barrier(0x008, 1, 0);
        __builtin_amdgcn_sched_group_barrier(0x100, 1, 0);
      }
      if (MI * NI > MI + NI) __builtin_amdgcn_sched_group_barrier(0x008, MI * NI - (MI + NI), 0);
    }
  }
}
template <int MI, int NI>
DI void gemm_first(const u16* A, long lda, const u16* B, long ldb, char* smem, int tid) {
  asm volatile("" : "+s"(A), "+s"(B));
  __syncthreads();
  g_issue<MI, NI>(A, lda, B, ldb, 0, smem, smem + 32768, tid);
  asm volatile("s_waitcnt vmcnt(0)" ::: "memory");
  __syncthreads();
}
template <int MI, int NI, bool DB = true, bool SW = false>
DI void gemm_k(f32x16 (&acc)[MI][NI], const u16* A, long lda, const u16* B, long ldb, int nkt, char* smem, int tid, bool has_next,
               const u16* nA, long nlda, const u16* nB, long nldb) {
  const int lane = tid & 63, wave = tid >> 6, wm = wave >> 2, wn = wave & 3;
  asm volatile("" : "+s"(A), "+s"(B), "+s"(nA), "+s"(nB));
  for (int kt = 0; kt < nkt; ++kt) {
    char* cur = smem + (kt & 1) * 65536;
    char* nxt = smem + ((kt & 1) ^ 1) * 65536;
    if (!DB) {
      if (kt + 1 < nkt) g_issue<MI, NI>(A, lda, B, ldb, (kt + 1) * 64, nxt, nxt + 32768, tid);
      else if (has_next) g_issue<MI, NI>(nA, nlda, nB, nldb, 0, nxt, nxt + 32768, tid);
      g_compute<MI, NI, false>(acc, cur, cur + 32768, wm, wn, lane);
      asm volatile("s_waitcnt vmcnt(0)" ::: "memory");
      __syncthreads();
      continue;
    }
    const bool late = (wave >= 4);
    const int r_ = lane & 31, h_ = lane >> 5, swz_ = (r_ >> 1) & 7;
    const int arow = wm * 32 * MI + r_, brow = wn * 32 * NI + r_;
    const char* cA = cur; const char* cB = cur + 32768;
    if (late) {
      g_step<MI, NI, SW>(acc, cA, cB, arow, brow, ((0 + h_) ^ swz_) << 4);
      g_step<MI, NI, SW>(acc, cA, cB, arow, brow, ((2 + h_) ^ swz_) << 4);
    }
    if (kt + 1 < nkt) g_issue<MI, NI>(A, lda, B, ldb, (kt + 1) * 64, nxt, nxt + 32768, tid);
    else if (has_next) g_issue<MI, NI>(nA, nlda, nB, nldb, 0, nxt, nxt + 32768, tid);
    if (!late) {
      g_step<MI, NI, SW>(acc, cA, cB, arow, brow, ((0 + h_) ^ swz_) << 4);
      g_step<MI, NI, SW>(acc, cA, cB, arow, brow, ((2 + h_) ^ swz_) << 4);
    }
    g_step<MI, NI, SW>(acc, cA, cB, arow, brow, ((4 + h_) ^ swz_) << 4);
    g_step<MI, NI, SW>(acc, cA, cB, arow, brow, ((6 + h_) ^ swz_) << 4);
    asm volatile("s_waitcnt vmcnt(0)" ::: "memory");
    __syncthreads();
  }
}
DI f32x4 mfma16(bf16x8 a, bf16x8 b, f32x4 c) { return __builtin_amdgcn_mfma_f32_16x16x32_bf16(a, b, c, 0, 0, 0); }
DI void g_step16(f32x4 (&acc)[8][4], const char* sA, const char* sB, int arow, int brow, int co) {
  bf16x8 b[4];
#pragma unroll
  for (int nb = 0; nb < 4; ++nb) b[nb] = *(const bf16x8*)(sB + (brow + nb * 16) * 128 + co);
#pragma unroll
  for (int mb = 0; mb < 8; ++mb) {
    const bf16x8 a = *(const bf16x8*)(sA + (arow + mb * 16) * 128 + co);
#pragma unroll
    for (int nb = 0; nb < 4; ++nb) acc[mb][nb] = mfma16(a, b[nb], acc[mb][nb]);
  }
}
DI void gemm_k16(f32x4 (&acc)[8][4], const u16* A, long lda, const u16* B, long ldb, int nkt, char* smem, int tid, bool has_next,
                 const u16* nA, long nlda, const u16* nB, long nldb) {
  const int lane = tid & 63, wave = tid >> 6, wm = wave >> 2, wn = wave & 3;
  asm volatile("" : "+s"(A), "+s"(B), "+s"(nA), "+s"(nB));
  const int r_ = lane & 15, q_ = lane >> 4, swz_ = (r_ >> 1) & 7;
  const int arow = wm * 128 + r_, brow = wn * 64 + r_;
  const bool late = (wave >= 4);
  for (int kt = 0; kt < nkt; ++kt) {
    char* cur = smem + (kt & 1) * 65536;
    char* nxt = smem + ((kt & 1) ^ 1) * 65536;
    const char* cA = cur; const char* cB = cur + 32768;
    if (late) g_step16(acc, cA, cB, arow, brow, ((0 + q_) ^ swz_) << 4);
    if (kt + 1 < nkt) g_issue<4, 2>(A, lda, B, ldb, (kt + 1) * 64, nxt, nxt + 32768, tid);
    else if (has_next) g_issue<4, 2>(nA, nlda, nB, nldb, 0, nxt, nxt + 32768, tid);
    if (!late) g_step16(acc, cA, cB, arow, brow, ((0 + q_) ^ swz_) << 4);
    g_step16(acc, cA, cB, arow, brow, ((4 + q_) ^ swz_) << 4);
    asm volatile("s_waitcnt vmcnt(0)" ::: "memory");
    __syncthreads();
  }
}
DI void zero_acc16(f32x4 (&acc)[8][4]) {
#pragma unroll
  for (int a = 0; a < 8; ++a)
#pragma unroll
    for (int b = 0; b < 4; ++b) acc[a][b] = (f32x4){0.f, 0.f, 0.f, 0.f};
}
template <int MI, int NI>
DI void zero_acc(f32x16 (&acc)[MI][NI]) {
#pragma unroll
  for (int a = 0; a < MI; ++a)
#pragma unroll
    for (int b = 0; b < NI; ++b) acc[a][b] = zero16();
}
DI bool tile_coords(int it, int NT, int SN, int total, int& mt, int& nt) {
  const int G = gridDim.x, b = blockIdx.x;
  int L = it * G + ((G & 7) == 0 ? ((b & 7) * (G >> 3) + (b >> 3)) : b);
  if (L >= total) return false;
  const int SM = 32 / SN, nst = NT / SN;
  const int stl = L >> 5, w = L & 31;
  const int stm = stl / nst, stn = stl - stm * nst;
  mt = stm * SM + w / SN;
  nt = stn * SN + (w % SN);
  return true;
}

template <bool VEC, class CM>
DI void conv_tile(const float* src, long ldsrc, int k0, u16* dst, long lddst, int n0, CM cm, float* sm, int tid) {
  const int r = tid >> 2, cc = (tid & 3) * 8;
  float v[8];
  const float* rowp = src + (long)(k0 + r) * ldsrc;
  if (VEC) {
    const int c0 = cm(cc);
    if (c0 >= 0) {
      float4 a = *(const float4*)(rowp + c0), b = *(const float4*)(rowp + c0 + 4);
      v[0] = a.x; v[1] = a.y; v[2] = a.z; v[3] = a.w; v[4] = b.x; v[5] = b.y; v[6] = b.z; v[7] = b.w;
    } else {
      for (int j = 0; j < 8; ++j) v[j] = 0.f;
    }
  } else {
#pragma unroll
    for (int j = 0; j < 8; ++j) { const int c = cm(cc + j); v[j] = c >= 0 ? rowp[c] : 0.f; }
  }
  __syncthreads();
#pragma unroll
  for (int j = 0; j < 8; ++j) sm[r * 33 + cc + j] = v[j];
  __syncthreads();
  const int n = tid >> 3, kc = (tid & 7) * 8;
  uint4 o;
  o.x = pack2(sm[(kc + 0) * 33 + n], sm[(kc + 1) * 33 + n]);
  o.y = pack2(sm[(kc + 2) * 33 + n], sm[(kc + 3) * 33 + n]);
  o.z = pack2(sm[(kc + 4) * 33 + n], sm[(kc + 5) * 33 + n]);
  o.w = pack2(sm[(kc + 6) * 33 + n], sm[(kc + 7) * 33 + n]);
  *(uint4*)(dst + (long)(n0 + n) * lddst + k0 + kc) = o;
}

constexpr int CV_FFN_IN = 4 * 88 * 16;
constexpr int CV_FFN_OUT = 4 * 16 * 44;
constexpr int CV_MIX = 2 * 96 * 16;
constexpr int CV_BRA = 2 * 16 * 4;
constexpr int CV_BRB = 2 * 16 * 2;
constexpr int CV_BRC = 2 * 16 * 6;
constexpr int CV_WOUT = 2 * 16 * 16;
constexpr int CV_C1 = 4 * 2 * 32;
constexpr int CV_C2 = 4 * 2 * 2;
constexpr int CV_TOTAL = CV_FFN_IN + CV_FFN_OUT + CV_MIX + CV_BRA + CV_BRB + CV_BRC + CV_WOUT + CV_C1 + CV_C2;
constexpr int P0_ADA = 144, P0_PEB = 4, P0_ROPE = 8;
constexpr int P0_TOTAL = CV_TOTAL + P0_ADA + P0_PEB + P0_ROPE;

DI void phase0_item(const Params& p, int idx, char* smem, int tid512) {
  const int half = tid512 >> 8, tid = tid512 & 255;
  float* sm = (float*)smem + half * (64 * 33);
  char* ws = p.ws;
  if (idx < P0_ADA) {
    const int lane = tid512 & 63, wave = tid512 >> 6;
    const int wi = idx * 8 + wave;
    const int l = wi / 576, rem = wi % 576, kc = rem / 36, cgp = rem % 36;
    const int col = cgp * 256 + lane * 4;
    f32x4 acc[8];
#pragma unroll
    for (int b = 0; b < 8; ++b) acc[b] = (f32x4){0.f, 0.f, 0.f, 0.f};
    for (int k0 = kc * 64; k0 < kc * 64 + 64; k0 += 8) {
      f32x4 w[8];
#pragma unroll
      for (int u = 0; u < 8; ++u) w[u] = *(const f32x4*)(p.ada_w + ((size_t)l * 1024 + k0 + u) * 9216 + col);
#pragma unroll
      for (int u = 0; u < 8; ++u)
#pragma unroll
        for (int b = 0; b < 8; ++b) {
          const float cb = siluf_(p.c[b * 1024 + k0 + u]);
          acc[b] += cb * w[u];
        }
    }
    float* part = (float*)(ws + OFF_MODPART) + (size_t)kc * (2 * 8 * 9216);
#pragma unroll
    for (int b = 0; b < 8; ++b) *(f32x4*)(part + ((size_t)l * 8 + b) * 9216 + col) = acc[b];
    return;
  }
  idx -= P0_ADA;
  if (idx < P0_PEB) {
    const int m = idx, colc = tid512 & 127, kq = tid512 >> 7;
    const float* pe = p.cmp_pe + (size_t)m * 2048;
    const float* w1 = p.cmp_w1 + (size_t)m * 2048 * 128;
    float a = 0.f;
    for (int k0 = kq * 512; k0 < kq * 512 + 512; k0 += 8) {
      float wv[8], pv8[8];
#pragma unroll
      for (int u = 0; u < 8; ++u) { wv[u] = w1[(size_t)(k0 + u) * 128 + colc]; pv8[u] = pe[k0 + u]; }
#pragma unroll
      for (int u = 0; u < 8; ++u) a += pv8[u] * wv[u];
    }
    float* smf = (float*)smem;
    __syncthreads();
    smf[tid512] = a;
    __syncthreads();
    if (tid512 < 128) ((float*)(ws + OFF_PEB))[m * 128 + tid512] = smf[tid512] + smf[tid512 + 128] + smf[tid512 + 256] + smf[tid512 + 384];
    return;
  }
  idx -= P0_PEB;
  if (idx < P0_ROPE) {
    const int t = idx * 512 + tid512;
    float* rp = (float*)(ws + OFF_ROPE) + (size_t)t * 16;
    for (int f = 0; f < 8; ++f) {
      const float inv = (float)pow(500000.0, -(double)f / 8.0);
      const float ang = (float)t * inv;
      rp[f] = (float)cos((double)ang);
      rp[8 + f] = (float)sin((double)ang);
    }
    if (idx == 0 && tid512 < 64) ((unsigned*)(ws + OFF_CTR))[tid512] = 0u;
    if (idx == 0) for (int i = tid512; i < 4096; i += 512) ((unsigned*)(ws + OFF_XBAR))[i] = 0u;
    return;
  }
  idx -= P0_ROPE;
  if (idx < CV_FFN_IN) {
    const int m = idx / (88 * 16), r = idx % (88 * 16), ng = (r / 16) * 2 + half, kt = r % 16;
    const int n0 = ng * 32;
    const int tile = n0 >> 8, within = n0 & 255, wn = within >> 6, r64 = within & 63, isup = r64 >> 5;
    const int c0 = tile * 128 + wn * 32 + (isup ? 2816 : 0);
    conv_tile<true>(p.ffn_w_in + (size_t)m * 1024 * 5632, 5632, kt * 64, (u16*)(ws + OFF_WFFN_IN + m * SZ_WFFN_IN), 1024, n0,
                    [=](int j) { return c0 + j; }, sm, tid);
    return;
  }
  idx -= CV_FFN_IN;
  if (idx < CV_FFN_OUT) {
    const int m = idx / (16 * 44), r = idx % (16 * 44), ng = (r / 44) * 2 + half, kt = r % 44;
    conv_tile<true>(p.ffn_w_out + (size_t)m * 2816 * 1024, 1024, kt * 64, (u16*)(ws + OFF_WFFN_OUT + m * SZ_WFFN_OUT), 2816,
                    ng * 32, [=](int j) { return ng * 32 + j; }, sm, tid);
    return;
  }
  idx -= CV_FFN_OUT;
  if (idx < CV_MIX) {
    const int l = idx / (96 * 16), r = idx % (96 * 16), ng = (r / 16) * 2 + half, kt = r % 16;
    const int n0 = ng * 32;
    conv_tile<false>(p.mix_w_in + (size_t)l * 1024 * 6034, 6034, kt * 64, (u16*)(ws + OFF_WMIX + l * SZ_WMIX), 1024, n0,
                     [=](int j) {
                       const int n = n0 + j;
                       if (n < 640) return n;
                       if (n < 1792) return 652 + (n - 640);
                       if (n < 2944) return 1804 + (n - 1792);
                       if (n < 3072) { const int g = n - 2944; return g < 12 ? 640 + g : (g < 18 ? 2956 + (g - 12) : -1); }
                       return 2962 + (n - 3072);
                     },
                     sm, tid);
    return;
  }
  idx -= CV_MIX;
  if (idx < CV_BRA) {
    const int l = idx / 64, r = idx % 64, ng = (r / 4) * 2 + half, kt = r % 4;
    conv_tile<true>(p.br_nsa + (size_t)l * 256 * 1024, 1024, kt * 64, (u16*)(ws + OFF_WBRA) + (size_t)l * 1024 * 256, 256, ng * 32,
                    [=](int j) { return ng * 32 + j; }, sm, tid);
    return;
  }
  idx -= CV_BRA;
  if (idx < CV_BRB) {
    const int l = idx / 32, r = idx % 32, ng = (r / 2) * 2 + half, kt = r % 2;
    conv_tile<true>(p.br_dil + (size_t)l * 128 * 1024, 1024, kt * 64, (u16*)(ws + OFF_WBRB) + (size_t)l * 1024 * 128, 128, ng * 32,
                    [=](int j) { return ng * 32 + j; }, sm, tid);
    return;
  }
  idx -= CV_BRB;
  if (idx < CV_BRC) {
    const int l = idx / 96, r = idx % 96, ng = (r / 6) * 2 + half, kt = r % 6;
    conv_tile<true>(p.br_fox + (size_t)l * 384 * 1024, 1024, kt * 64, (u16*)(ws + OFF_WBRC) + (size_t)l * 1024 * 384, 384, ng * 32,
                    [=](int j) { return ng * 32 + j; }, sm, tid);
    return;
  }
  idx -= CV_BRC;
  if (idx < CV_WOUT) {
    const int l = idx / 256, r = idx % 256, ng = (r / 16) * 2 + half, kt = r % 16;
    conv_tile<true>(p.mix_w_out + (size_t)l * 1024 * 1024, 1024, kt * 64, (u16*)(ws + OFF_WOUT) + (size_t)l * 1024 * 1024, 1024,
                    ng * 32, [=](int j) { return ng * 32 + j; }, sm, tid);
    return;
  }
  idx -= CV_WOUT;
  if (idx < CV_C1) {
    const int m = idx / 64, r = idx % 64, ng = (r / 32) * 2 + half, kt = r % 32;
    conv_tile<true>(p.cmp_w1 + (size_t)m * 2048 * 128, 128, kt * 64, (u16*)(ws + OFF_WC1) + (size_t)m * 128 * 2048, 2048, ng * 32,
                    [=](int j) { return ng * 32 + j; }, sm, tid);
    return;
  }
  idx -= CV_C1;
  if (idx < CV_C2) {
    const int m = idx / 4, r = idx % 4, ng = (r / 2) * 2 + half, kt = r % 2;
    conv_tile<true>(p.cmp_w2 + (size_t)m * 128 * 64, 64, kt * 64, (u16*)(ws + OFF_WC2) + (size_t)m * 128 * 128, 128, ng * 32,
                    [=](int j) { return ng < 2 ? ng * 32 + j : -1; }, sm, tid);
    return;
  }
  idx -= CV_C2;
}

DI void norm_phase(const Params& p, const float* hin, int l, int sub, int tid) {
  const int lane = tid & 63, wave = tid >> 6;
  const float* g = p.norm_g + ((size_t)l * 3 + sub) * 1024;
  const float* mod = (const float*)(p.ws + OFF_MOD) + (size_t)l * 8 * 9216;
  u16* nb = (u16*)(p.ws + OFF_NBUF);
  for (int r = blockIdx.x * 8 + wave; r < T; r += gridDim.x * 8) {
    const int b = r >> 12;
    const f32x4* src = (const f32x4*)(hin + (size_t)r * 1024);
    f32x4 v[4];
    float ss = 0.f;
#pragma unroll
    for (int j = 0; j < 4; ++j) {
      v[j] = src[lane + 64 * j];
      ss += v[j].x * v[j].x + v[j].y * v[j].y + v[j].z * v[j].z + v[j].w * v[j].w;
    }
    for (int o = 32; o; o >>= 1) ss += __shfl_xor(ss, o);
    const float rs = rsqrtf(ss * (1.f / 1024.f) + 1e-6f);
    const float4* sh = (const float4*)(mod + (size_t)b * 9216 + (3 * sub) * 1024);
    const float4* sc = (const float4*)(mod + (size_t)b * 9216 + (3 * sub + 1) * 1024);
#pragma unroll
    for (int j = 0; j < 4; ++j) {
      const float4 gg = ((const float4*)g)[lane + 64 * j], s4 = sh[lane + 64 * j], c4 = sc[lane + 64 * j];
      const float a = v[j].x * rs * gg.x * (1.f + c4.x) + s4.x;
      const float bq = v[j].y * rs * gg.y * (1.f + c4.y) + s4.y;
      const float cq = v[j].z * rs * gg.z * (1.f + c4.z) + s4.z;
      const float dq = v[j].w * rs * gg.w * (1.f + c4.w) + s4.w;
      uint2 o; o.x = pack2(a, bq); o.y = pack2(cq, dq);
      *(uint2*)(nb + (size_t)r * 1024 + (lane + 64 * j) * 4) = o;
    }
  }
}

DI bool ffn1_coords(int it, int& mt, int& nt) {
  const int G = gridDim.x, b = blockIdx.x;
  int L = it * G + ((G & 7) == 0 ? ((b & 7) * (G >> 3) + (b >> 3)) : b);
  if (L >= 128 * 22) return false;
  if (L < 2560) {
    const int stl = L >> 5, w = L & 31, stm = stl / 5, stn = stl - stm * 5;
    mt = stm * 8 + (w >> 2); nt = stn * 4 + (w & 3);
  } else {
    const int L2 = L - 2560, stl = L2 >> 5, w = L2 & 31;
    mt = stl * 16 + (w >> 1); nt = 20 + (w & 1);
  }
  return true;
}
DI void ffn1_phase(const Params& p, int l, int f, char* smem, int tid) {
  const u16* A = (const u16*)(p.ws + OFF_NBUF);
  const u16* W = (const u16*)(p.ws + OFF_WFFN_IN + (size_t)(l * 2 + f) * SZ_WFFN_IN);
  u16* hid = (u16*)(p.ws + A_HID);
  const int lane = tid & 63, wave = tid >> 6, wm = wave >> 2, wn = wave & 3, q_ = lane >> 4, c_ = lane & 15;
  int mt, nt, mt2 = 0, nt2 = 0;
  bool have = ffn1_coords(0, mt, nt);
  if (have) gemm_first<4, 2>(A + (size_t)mt * 256 * 1024, 1024, W + (size_t)nt * 256 * 1024, 1024, smem, tid);
  for (int it = 0; have; ++it, mt = mt2, nt = nt2) {
    const bool have2 = ffn1_coords(it + 1, mt2, nt2);
    if (!have2) { mt2 = mt; nt2 = nt; }
    have = have2;
    f32x4 acc[8][4];
    zero_acc16(acc);
    gemm_k16(acc, A + (size_t)mt * 256 * 1024, 1024, W + (size_t)nt * 256 * 1024, 1024, 16, smem, tid, have2,
             A + (size_t)mt2 * 256 * 1024, 1024, W + (size_t)nt2 * 256 * 1024, 1024);
    const int q = launder_i(q_), c = launder_i(c_);
    const unsigned ebase = (unsigned)(mt * 256 + wm * 128 + 4 * q) * (unsigned)DFF + (unsigned)(nt * 128 + wn * 32 + c);
#pragma unroll
    for (int mb = 0; mb < 8; ++mb)
#pragma unroll
      for (int nb = 0; nb < 2; ++nb)
#pragma unroll
        for (int i = 0; i < 4; ++i)
          hid[ebase + (unsigned)(mb * 16 + i) * (unsigned)DFF + (unsigned)(nb * 16)] = f2bf(siluf_(acc[mb][nb][i]) * acc[mb][nb + 2][i]);
  }
}

DI void resid_gemm_phase(const Params& p, const u16* A, int K, const u16* W, const float* hin, float* hout, int l, int gachunk,
                         float scale, char* smem, int tid) {
  const int lane = tid & 63, wave = tid >> 6, wm = wave >> 2, wn = wave & 3, h_ = lane >> 5, c_ = lane & 31;
  const float* mod = (const float*)(p.ws + OFF_MOD) + (size_t)l * 8 * 9216 + gachunk * 1024;
  int mt, nt, mt2 = 0, nt2 = 0;
  bool have = tile_coords(0, 4, 4, 128 * 4, mt, nt);
  if (have) gemm_first<4, 2>(A + (size_t)mt * 256 * K, K, W + (size_t)nt * 256 * K, K, smem, tid);
  for (int it = 0; have; ++it, mt = mt2, nt = nt2) {
    const bool have2 = tile_coords(it + 1, 4, 4, 128 * 4, mt2, nt2);
    if (!have2) { mt2 = mt; nt2 = nt; }
    have = have2;
    f32x16 acc[4][2];
    zero_acc<4, 2>(acc);
    gemm_k<4, 2>(acc, A + (size_t)mt * 256 * K, K, W + (size_t)nt * 256 * K, K, K / 64, smem, tid, have2,
                 A + (size_t)mt2 * 256 * K, K, W + (size_t)nt2 * 256 * K, K);
    const int h = launder_i(h_), c = launder_i(c_);
    const int b = (mt * 256) >> 12;
#pragma unroll
    for (int ni = 0; ni < 2; ++ni) {
      const int col = nt * 256 + wn * 64 + ni * 32 + c;
      const float ga = mod[(size_t)b * 9216 + col] * scale;
      const unsigned ebase = (unsigned)(mt * 256 + wm * 128 + 4 * h) * 1024u + (unsigned)col;
#pragma unroll
      for (int mi = 0; mi < 4; ++mi) {
#pragma unroll
        for (int i = 0; i < 16; ++i) {
          const unsigned eo = ebase + (unsigned)(mi * 32 + (i & 3) + 8 * (i >> 2)) * 1024u;
          hout[eo] = hin[eo] + ga * acc[mi][ni][i];
        }
        __builtin_amdgcn_sched_barrier(0);
      }
    }
  }
}

DI void inproj_phase(const Params& p, int l, char* smem, int tid) {
  const u16* A = (const u16*)(p.ws + OFF_NBUF);
  const u16* W = (const u16*)(p.ws + OFF_WMIX + (size_t)l * SZ_WMIX);
  const float* rope = (const float*)(p.ws + OFF_ROPE);
  char* ws = p.ws;
  const int lane = tid & 63, wave = tid >> 6, wm = wave >> 2, wn = wave & 3, h_ = lane >> 5, c_ = lane & 31;
  int mt, nt, mt2 = 0, nt2 = 0;
  bool have = tile_coords(0, 12, 4, 128 * 12, mt, nt);
  if (have) gemm_first<4, 2>(A + (size_t)mt * 256 * 1024, 1024, W + (size_t)nt * 256 * 1024, 1024, smem, tid);
  for (int it = 0; have; ++it, mt = mt2, nt = nt2) {
    const bool have2 = tile_coords(it + 1, 12, 4, 128 * 12, mt2, nt2);
    if (!have2) { mt2 = mt; nt2 = nt; }
    have = have2;
    f32x16 acc[4][2];
    zero_acc<4, 2>(acc);
    gemm_k<4, 2, true, true>(acc, A + (size_t)mt * 256 * 1024, 1024, W + (size_t)nt * 256 * 1024, 1024, 16, smem, tid, have2,
                             A + (size_t)mt2 * 256 * 1024, 1024, W + (size_t)nt2 * 256 * 1024, 1024);
    const int h = launder_i(h_), c = launder_i(c_);
    const int hidx = nt * 4 + wn;
    const int rowbase = mt * 256 + wm * 128;
    const int b = rowbase >> 12;
    if (hidx == 47) continue;
    if (hidx == 46) {
#pragma unroll
      for (int mi = 0; mi < 4; ++mi) {
        const size_t row = (size_t)rowbase + mi * 32 + c;
#pragma unroll
        for (int i = 0; i < 12; ++i) {
          const int d = (i & 3) + 8 * (i >> 2) + 4 * h;
          const float v = acc[mi][0][i];
          if (d < 12) {
            ((float*)(ws + A_GNSA))[row * 12 + d] = v;
          } else if (d < 18) {
            const float xx = v + p.fox_bias[l * 6 + (d - 12)];
            ((float*)(ws + A_FLOG))[row * 6 + (d - 12)] = fminf(xx, 0.f) - log1pf(__expf(-fabsf(xx)));
          }
        }
        __builtin_amdgcn_sched_barrier(0);
      }
      continue;
    }
    bool do_rope, transposed;
    int pg = 0;
    u16* dst;
    int ld = 64, col0 = 0, nh = 1, hh = 0;
    if (hidx < 4) { dst = (u16*)(ws + A_QNSA); ld = 256; col0 = hidx * 64; do_rope = true; transposed = false; }
    else if (hidx < 10) {
      const int k = hidx - 4;
      dst = (u16*)(ws + (k == 0 ? A_KCMP : k == 1 ? A_VCMP : k == 2 ? A_KSEL : k == 3 ? A_VSELT : k == 4 ? A_KWIN : A_VWINT));
      do_rope = (k & 1) == 0; transposed = (k == 3 || k == 5);
    } else if (hidx < 28) {
      const int k = hidx - 10, which = k / 6; hh = k % 6; pg = hh >> 1; nh = 6;
      if (which == 0) { dst = (u16*)(ws + A_DQ); ld = 384; col0 = hh * 64; do_rope = true; transposed = false; }
      else if (which == 1) { dst = (u16*)(ws + A_DK); ld = 384; col0 = hh * 64; do_rope = true; transposed = false; }
      else { dst = (u16*)(ws + A_DVT); do_rope = false; transposed = true; }
    } else {
      const int k = hidx - 28, which = k / 6; hh = k % 6; nh = 6;
      do_rope = false;
      if (which == 0) { dst = (u16*)(ws + A_FQ); ld = 384; col0 = hh * 64; transposed = false; }
      else if (which == 1) { dst = (u16*)(ws + A_FK); ld = 384; col0 = hh * 64; transposed = false; }
      else { dst = (u16*)(ws + A_FVT); transposed = true; }
    }
    const int dl = pg * 2;
#pragma unroll
    for (int mi = 0; mi < 4; ++mi) {
      __builtin_amdgcn_sched_barrier(0);
      const int t = (rowbase + mi * 32 + c) & (S - 1);
      const int pidx = ((t & ((1 << dl) - 1)) << (12 - dl)) + (t >> dl);
      if (do_rope) {
        const f32x4 cs = *(const f32x4*)(rope + t * 16 + 4 * h), sn = *(const f32x4*)(rope + t * 16 + 8 + 4 * h);
#pragma unroll
        for (int i = 0; i < 4; ++i) {
          const float x1 = acc[mi][0][i], x2 = acc[mi][0][i + 4];
          const float cc = i == 0 ? cs.x : i == 1 ? cs.y : i == 2 ? cs.z : cs.w;
          const float ss = i == 0 ? sn.x : i == 1 ? sn.y : i == 2 ? sn.z : sn.w;
          acc[mi][0][i] = x1 * cc - x2 * ss;
          acc[mi][0][i + 4] = x2 * cc + x1 * ss;
        }
      }
      if (!transposed) {
        const unsigned obase = (unsigned)(b * S + pidx) * (unsigned)ld + (unsigned)(col0 + 4 * h);
#pragma unroll
        for (int ni = 0; ni < 2; ++ni) {
#pragma unroll
          for (int g4 = 0; g4 < 4; ++g4) {
            u32x2 o;
            o.x = pack2(acc[mi][ni][4 * g4 + 0], acc[mi][ni][4 * g4 + 1]);
            o.y = pack2(acc[mi][ni][4 * g4 + 2], acc[mi][ni][4 * g4 + 3]);
            *(u32x2*)(dst + (obase + (unsigned)(ni * 32 + 8 * g4))) = o;
          }
          __builtin_amdgcn_sched_barrier(0);
        }
      } else {
        const unsigned obase = (unsigned)((b * nh + hh) * 64 + 4 * h) * (unsigned)S + (unsigned)pidx;
#pragma unroll
        for (int ni = 0; ni < 2; ++ni) {
#pragma unroll
          for (int i = 0; i < 16; ++i)
            dst[obase + (unsigned)(ni * 32 + (i & 3) + 8 * (i >> 2)) * (unsigned)S] = f2bf(acc[mi][ni][i]);
          __builtin_amdgcn_sched_barrier(0);
        }
      }
    }
  }
}

DI void cmp1_phase(const Params& p, int l, char* smem, int tid) {
  const int lane = tid & 63, wave = tid >> 6, wm = wave >> 2, wn = wave & 3, h_ = lane >> 5, c_ = lane & 31;
  char* ws = p.ws;
  for (int item = blockIdx.x; item < 16 + 6; item += gridDim.x) {
    if (item < 16) {
      const int b = item >> 1, j = item & 1;
      const u16* A = (const u16*)(ws + (j ? A_VCMP : A_KCMP)) + (size_t)b * S * 64;
      const u16* W = (const u16*)(ws + OFF_WC1) + (size_t)(l * 2 + j) * 128 * 2048;
      const float* peb = (const float*)(ws + OFF_PEB) + (l * 2 + j) * 128;
      f32x16 acc[4][1];
      zero_acc<4, 1>(acc);
      gemm_first<4, 1>(A, 1024, W, 2048, smem, tid);
      gemm_k<4, 1>(acc, A, 1024, W, 2048, 32, smem, tid, false, A, 1024, W, 2048);
      const int h = launder_i(h_), c = launder_i(c_);
      u16* hc = (u16*)(ws + A_HIDC) + (size_t)(b * 2 + j) * 256 * 128;
      const int col = wn * 32 + c;
      const float pb = peb[col];
#pragma unroll
      for (int mi = 0; mi < 4; ++mi)
#pragma unroll
        for (int i = 0; i < 16; ++i) {
          const int row = wm * 128 + mi * 32 + crow(i, h);
          hc[(size_t)row * 128 + col] = f2bf(siluf_(acc[mi][0][i] + pb));
        }
    } else {
      const int wi = (item - 16) * 8 + wave;
      const int b = wi / 6, hd = wi % 6;
      const float* fl = (const float*)(ws + A_FLOG) + (size_t)b * S * 6 + hd;
      float* cum = (float*)(ws + A_CUM) + (size_t)(b * 6 + hd) * S;
      float ssum = 0.f;
      for (int k = 0; k < 64; ++k) ssum += fl[(size_t)(lane * 64 + k) * 6];
      float incl = ssum;
      for (int o = 1; o < 64; o <<= 1) { const float v = __shfl_up(incl, o); if (lane >= o) incl += v; }
      float run = incl - ssum;
      for (int k = 0; k < 64; ++k) { run += fl[(size_t)(lane * 64 + k) * 6]; cum[lane * 64 + k] = run; }
    }
  }
}
DI void cmp2_phase(const Params& p, int l, char* smem, int tid) {
  const int lane = tid & 63, wave = tid >> 6, wm = wave >> 2, wn = wave & 3, h_ = lane >> 5, c_ = lane & 31;
  char* ws = p.ws;
  for (int item = blockIdx.x; item < 16; item += gridDim.x) {
    const int b = item >> 1, j = item & 1;
    const u16* A = (const u16*)(ws + A_HIDC) + (size_t)(b * 2 + j) * 256 * 128;
    const u16* W = (const u16*)(ws + OFF_WC2) + (size_t)(l * 2 + j) * 128 * 128;
    f32x16 acc[4][1];
    zero_acc<4, 1>(acc);
    gemm_first<4, 1>(A, 128, W, 128, smem, tid);
    gemm_k<4, 1>(acc, A, 128, W, 128, 2, smem, tid, false, A, 128, W, 128);
    const int h = launder_i(h_), c = launder_i(c_);
    if (wn < 2) {
      const int d = wn * 32 + c;
#pragma unroll
      for (int mi = 0; mi < 4; ++mi)
#pragma unroll
        for (int i = 0; i < 16; ++i) {
          const int row = wm * 128 + mi * 32 + crow(i, h);
          const float v = row < 255 ? acc[mi][0][i] : 0.f;
          if (j == 0) ((u16*)(ws + A_KC))[((size_t)b * 256 + row) * 64 + d] = f2bf(v);
          else ((u16*)(ws + A_VCT))[((size_t)b * 64 + d) * 256 + row] = f2bf(v);
        }
    }
  }
}

constexpr int SM_K = 0;
constexpr int SM_V = 16384;
constexpr int SM_KB = 33792;
constexpr int SM_IMP = 34304;
constexpr int SM_SEL = 99840;
constexpr int SM_ITEM = 100352;
constexpr int SM_YP = 100608;

struct AttnSt { f32x16 o0, o1; float m, l; };
DI void attn_init(AttnSt& st) { st.o0 = zero16(); st.o1 = zero16(); st.m = -1e30f; st.l = 0.f; }

struct KVStage { u32x4 k, v; float kb; };
template <bool BIAS, bool LOADV>
DI void kv_load(KVStage& s, const u16* Kg, long ldk, const u16* Vt, long ldv, const float* kb, int key0, int tid) {
  const unsigned ch = (tid & 7) * 8, r0 = tid >> 3;
  const unsigned lk = (unsigned)ldk, lv = (unsigned)ldv;
  s.k = *(const u32x4*)(Kg + ((key0 + r0) * lk + ch));
  if (LOADV) s.v = *(const u32x4*)(Vt + (r0 * lv + key0 + ch));
  if (BIAS) { if (tid < 64) s.kb = kb[key0 + tid] * LOG2E; }
}
template <bool BIAS, bool LOADV>
DI void kv_store(const KVStage& s, char* smem, int buf, int tid) {
  const int r0 = tid >> 3, chn = tid & 7;
  const int sw = ((chn ^ ((r0 >> 1) & 7)) << 4);
  *(u32x4*)(smem + SM_K + buf * 8192 + r0 * 128 + sw) = s.k;
  if (LOADV) {
    char* vp = smem + SM_V + buf * 8704 + r0 * 136 + chn * 16;
    *(u32x2*)(vp) = s.v.xy;
    *(u32x2*)(vp + 8) = s.v.zw;
  }
  if (BIAS) { if (tid < 64) ((float*)(smem + SM_KB + buf * 256))[tid] = s.kb; }
}
DI void st_compute(f32x16 (&sacc)[2], const bf16x8 (&qf)[4], const char* kbuf, int lane) {
  const int r = lane & 31, h = lane >> 5, swz = (r >> 1) & 7;
#pragma unroll
  for (int u = 0; u < 2; ++u) {
    sacc[u] = zero16();
#pragma unroll
    for (int s = 0; s < 4; ++s) {
      const bf16x8 kf = *(const bf16x8*)(kbuf + (32 * u + r) * 128 + (((2 * s + h) ^ swz) << 4));
      sacc[u] = mfma32(kf, qf[s], sacc[u]);
    }
  }
}
template <int MODE>
DI bool key_ok(int key, int tq, int W, u64 selm, int kt) {
  if (MODE == 0) return key <= tq;
  if (MODE == 1) return key <= tq && key > tq - W;
  if (MODE == 2) return ((selm >> kt) & 1ull) && key <= tq;
  return 16 * key + 31 <= tq;
}
template <int MODE, bool BIAS>
DI void attn_loop(AttnSt& st, const bf16x8 (&qf)[4], const u16* Kg, long ldk, const u16* Vt, long ldv, const float* kb, int kt0,
                  int kt1, int tq, int W, u64 selm, float cq2, char* smem, int tid) {
  if (kt0 >= kt1) return;
  const int lane = tid & 63, r = lane & 31, h = lane >> 5;
  const int tq_min = __builtin_amdgcn_readfirstlane(tq - r), tq_max = tq_min + 31;
  KVStage kv;
  kv_load<BIAS, true>(kv, Kg, ldk, Vt, ldv, kb, kt0 * 64, tid);
  __syncthreads();
  kv_store<BIAS, true>(kv, smem, 0, tid);
  __syncthreads();
  for (int kt = kt0; kt < kt1; ++kt) {
    const int buf = (kt - kt0) & 1;
    if (kt + 1 < kt1) kv_load<BIAS, true>(kv, Kg, ldk, Vt, ldv, kb, (kt + 1) * 64, tid);
    const int key0 = kt * 64;
    bool active;
    if (MODE == 3) active = (16 * key0 + 31 <= tq_max);
    else if (MODE == 1) active = (key0 <= tq_max) && (key0 + 63 > tq_min - W);
    else active = (key0 <= tq_max);
    if (active) {
      f32x16 sacc[2];
      st_compute(sacc, qf, smem + SM_K + buf * 8192, lane);
      const float* kbs = (const float*)(smem + SM_KB + buf * 256);
      bool full;
      if (MODE == 3) full = (16 * (key0 + 63) + 31 <= tq_min);
      else if (MODE == 1) full = (key0 + 63 <= tq_min) && (key0 > tq_max - W);
      else full = (key0 + 63 <= tq_min);
      float alpha, rs = 0.f;
      if (full) {
        const bool lsel = (MODE == 2) ? (((selm >> kt) & 1ull) != 0ull) : true;
        float mx = -3e38f;
#pragma unroll
        for (int u = 0; u < 2; ++u)
#pragma unroll
          for (int g4 = 0; g4 < 4; ++g4) {
            f32x4 kb4 = {0.f, 0.f, 0.f, 0.f};
            if (BIAS) kb4 = *(const f32x4*)(kbs + 32 * u + 8 * g4 + 4 * h);
#pragma unroll
            for (int e2 = 0; e2 < 4; ++e2) {
              const int i = 4 * g4 + e2;
              if (BIAS) sacc[u][i] = __builtin_fmaf(sacc[u][i], SC2, -(e2 == 0 ? kb4.x : e2 == 1 ? kb4.y : e2 == 2 ? kb4.z : kb4.w));
              mx = fmaxf(mx, sacc[u][i]);
            }
          }
        if (!BIAS) mx *= SC2;
        if (MODE == 2) mx = lsel ? mx : -1e30f;
        mx = fmaxf(mx, __shfl_xor(mx, 32));
        const float mnew = fmaxf(st.m, mx);
        alpha = __builtin_amdgcn_exp2f(st.m - mnew);
        st.m = mnew;
#pragma unroll
        for (int u = 0; u < 2; ++u)
#pragma unroll
          for (int i = 0; i < 16; ++i) {
            float pv = BIAS ? __builtin_amdgcn_exp2f(sacc[u][i] - mnew) : __builtin_amdgcn_exp2f(__builtin_fmaf(sacc[u][i], SC2, -mnew));
            if (MODE == 2) pv = lsel ? pv : 0.f;
            rs += pv;
            sacc[u][i] = pv;
          }
      } else {
        float mx = -1e30f;
#pragma unroll
        for (int u = 0; u < 2; ++u)
#pragma unroll
          for (int g4 = 0; g4 < 4; ++g4) {
            f32x4 kb4 = {0.f, 0.f, 0.f, 0.f};
            if (BIAS) kb4 = *(const f32x4*)(kbs + 32 * u + 8 * g4 + 4 * h);
#pragma unroll
            for (int e2 = 0; e2 < 4; ++e2) {
              const int i = 4 * g4 + e2;
              const int key = key0 + 32 * u + 8 * g4 + 4 * h + e2;
              float s2 = sacc[u][i] * SC2;
              if (BIAS) s2 -= (e2 == 0 ? kb4.x : e2 == 1 ? kb4.y : e2 == 2 ? kb4.z : kb4.w);
              s2 = key_ok<MODE>(key, tq, W, selm, kt) ? s2 : -1e30f;
              sacc[u][i] = s2;
              mx = fmaxf(mx, s2);
            }
          }
        mx = fmaxf(mx, __shfl_xor(mx, 32));
        const float mnew = fmaxf(st.m, mx);
        alpha = __builtin_amdgcn_exp2f(st.m - mnew);
        st.m = mnew;
#pragma unroll
        for (int u = 0; u < 2; ++u)
#pragma unroll
          for (int i = 0; i < 16; ++i) {
            const float s2 = sacc[u][i];
            const float pv = (s2 <= -1e29f) ? 0.f : __builtin_amdgcn_exp2f(s2 - mnew);
            rs += pv;
            sacc[u][i] = pv;
          }
      }
      st.l = st.l * alpha + rs;
#pragma unroll
      for (int i = 0; i < 16; ++i) { st.o0[i] *= alpha; st.o1[i] *= alpha; }
      const char* vbuf = smem + SM_V + buf * 8704;
#pragma unroll
      for (int u = 0; u < 2; ++u)
#pragma unroll
        for (int s2i = 0; s2i < 2; ++s2i) {
          unsigned pk[4];
#pragma unroll
          for (int j = 0; j < 4; ++j) pk[j] = pack2(sacc[u][8 * s2i + 2 * j], sacc[u][8 * s2i + 2 * j + 1]);
          const u32x4 pk4 = {pk[0], pk[1], pk[2], pk[3]};
          const bf16x8 pf = __builtin_bit_cast(bf16x8, pk4);
          const int koff = (32 * u + 16 * s2i + 4 * h) * 2;
          {
            const char* vp = vbuf + r * 136 + koff;
            const u32x2 lo = *(const u32x2*)vp, hi = *(const u32x2*)(vp + 16);
            const u32x4 v4 = {lo.x, lo.y, hi.x, hi.y};
            const bf16x8 vf = __builtin_bit_cast(bf16x8, v4);
            st.o0 = mfma32(vf, pf, st.o0);
          }
          {
            const char* vp = vbuf + (32 + r) * 136 + koff;
            const u32x2 lo = *(const u32x2*)vp, hi = *(const u32x2*)(vp + 16);
            const u32x4 v4 = {lo.x, lo.y, hi.x, hi.y};
            const bf16x8 vf = __builtin_bit_cast(bf16x8, v4);
            st.o1 = mfma32(vf, pf, st.o1);
          }
        }
    }
    if (kt + 1 < kt1) kv_store<BIAS, true>(kv, smem, buf ^ 1, tid);
    __syncthreads();
  }
}
DI void load_q(bf16x8 (&qf)[4], const u16* qrow, int lane) {
  const int h = lane >> 5;
#pragma unroll
  for (int s = 0; s < 4; ++s) qf[s] = *(const bf16x8*)(qrow + 16 * s + 8 * h);
}

DI void nsa_item(const Params& p, int b, int qt, char* smem, int tid) {
  char* ws = p.ws;
  const int lane = tid & 63, wave = tid >> 6, head = wave & 3, qh = wave >> 2, r = lane & 31, h = lane >> 5;
  const int q0 = qt * 64, tq = q0 + 32 * qh + r, ql = 32 * qh + r;
  const size_t row = (size_t)b * S + tq;
  bf16x8 qf[4];
  load_q(qf, (const u16*)(ws + A_QNSA) + row * 256 + head * 64, lane);
  float* imp = (float*)(smem + SM_IMP);
  u64* selp = (u64*)(smem + SM_SEL);
  __syncthreads();
  for (int i = tid; i < 4 * 64 * 64; i += 512) imp[i] = 0.f;
  const float* gl = (const float*)(ws + A_GNSA) + row * 12 + head * 3;
  const float g0 = sigmoidf_(gl[0]), g1 = sigmoidf_(gl[1]), g2 = sigmoidf_(gl[2]);
  unsigned* yp = (unsigned*)(smem + SM_YP) + wave * 16 * 64 + lane;
  const u16* KC = (const u16*)(ws + A_KC) + (size_t)b * 256 * 64;
  const u16* VCT = (const u16*)(ws + A_VCT) + (size_t)b * 64 * 256;
  const int ktc = ((q0 + 32) >> 10) + 1;
  AttnSt st;
  attn_init(st);
  attn_loop<3, false>(st, qf, KC, 64, VCT, 256, nullptr, 0, ktc, tq, 0, 0ull, 0.f, smem, tid);
  {
    float lt = st.l + __shfl_xor(st.l, 32);
    const float inv = lt > 0.f ? 1.f / lt : 0.f;
    const float gs = g0 * inv;
#pragma unroll
    for (int i = 0; i < 8; ++i) {
      yp[i * 64] = pack2(st.o0[2 * i] * gs, st.o0[2 * i + 1] * gs);
      yp[(8 + i) * 64] = pack2(st.o1[2 * i] * gs, st.o1[2 * i + 1] * gs);
    }
    for (int kt = 0; kt < ktc; ++kt) {
      KVStage kv;
      kv_load<false, false>(kv, KC, 64, VCT, 256, nullptr, kt * 64, tid);
      __syncthreads();
      kv_store<false, false>(kv, smem, 0, tid);
      __syncthreads();
      f32x16 sacc[2];
      st_compute(sacc, qf, smem + SM_K, lane);
#pragma unroll
      for (int u = 0; u < 2; ++u)
#pragma unroll
        for (int g4 = 0; g4 < 4; ++g4) {
          float pv[4];
#pragma unroll
          for (int e = 0; e < 4; ++e) {
            const int key = kt * 64 + 32 * u + 8 * g4 + 4 * h + e;
            const float s2 = sacc[u][4 * g4 + e] * SC2;
            pv[e] = (16 * key + 31 <= tq) ? __builtin_amdgcn_exp2f(s2 - st.m) * inv : 0.f;
          }
          const int j = kt * 16 + 8 * u + 2 * g4 + h;
          atomicAdd(&imp[(head * 64 + ql) * 64 + j], pv[0] + pv[1] + pv[2] + 0.5f * pv[3]);
          if (j + 1 < 64) atomicAdd(&imp[(head * 64 + ql) * 64 + j + 1], 0.5f * pv[3]);
        }
    }
  }
  __syncthreads();
  for (int qi = 0; qi < 8; ++qi) {
    const int q = wave * 8 + qi, t = q0 + q, cur = t >> 6, j = lane;
    const float v = (imp[q * 64 + j] + imp[(64 + q) * 64 + j]) + (imp[(128 + q) * 64 + j] + imp[(192 + q) * 64 + j]);
    const float val = (j == cur || j == 0) ? 1e4f : (j <= cur ? v : -1.f);
    int rank = 0;
#pragma unroll
    for (int jj = 0; jj < 64; ++jj) {
      const float o = __int_as_float(__builtin_amdgcn_readlane(__float_as_int(val), jj));
      rank += (o > val || (o == val && jj < j)) ? 1 : 0;
    }
    const u64 mask = __ballot(rank < 16);
    if (lane == 0) selp[q] = mask;
  }
  __syncthreads();
  const u64 selm = selp[ql];
  attn_init(st);
  attn_loop<2, false>(st, qf, (const u16*)(ws + A_KSEL) + (size_t)b * S * 64, 64, (const u16*)(ws + A_VSELT) + (size_t)b * 64 * S, S,
                      nullptr, 0, ((q0 + 63) >> 6) + 1, tq, 0, selm, 0.f, smem, tid);
  {
    float lt = st.l + __shfl_xor(st.l, 32);
    const float gs = lt > 0.f ? g1 / lt : 0.f;
#pragma unroll
    for (int i = 0; i < 8; ++i) {
      const unsigned a = yp[i * 64], bq = yp[(8 + i) * 64];
      yp[i * 64] = pack2(__uint_as_float(a << 16) + st.o0[2 * i] * gs, __uint_as_float(a & 0xffff0000u) + st.o0[2 * i + 1] * gs);
      yp[(8 + i) * 64] = pack2(__uint_as_float(bq << 16) + st.o1[2 * i] * gs, __uint_as_float(bq & 0xffff0000u) + st.o1[2 * i + 1] * gs);
    }
  }
  attn_init(st);
  {
    const int lo = q0 - 511;
    attn_loop<1, false>(st, qf, (const u16*)(ws + A_KWIN) + (size_t)b * S * 64, 64, (const u16*)(ws + A_VWINT) + (size_t)b * 64 * S, S,
                        nullptr, (lo > 0 ? lo : 0) >> 6, ((q0 + 63) >> 6) + 1, tq, 512, 0ull, 0.f, smem, tid);
    float lt = st.l + __shfl_xor(st.l, 32);
    const float gs = lt > 0.f ? g2 / lt : 0.f;
    u16* ya = (u16*)(ws + A_YA) + row * 256 + head * 64;
#pragma unroll
    for (int g4 = 0; g4 < 4; ++g4) {
      u32x2 o;
      unsigned a = yp[(2 * g4) * 64], bq = yp[(2 * g4 + 1) * 64];
      o.x = pack2(__uint_as_float(a << 16) + st.o0[4 * g4] * gs, __uint_as_float(a & 0xffff0000u) + st.o0[4 * g4 + 1] * gs);
      o.y = pack2(__uint_as_float(bq << 16) + st.o0[4 * g4 + 2] * gs, __uint_as_float(bq & 0xffff0000u) + st.o0[4 * g4 + 3] * gs);
      *(u32x2*)(ya + 8 * g4 + 4 * h) = o;
      a = yp[(8 + 2 * g4) * 64]; bq = yp[(8 + 2 * g4 + 1) * 64];
      o.x = pack2(__uint_as_float(a << 16) + st.o1[4 * g4] * gs, __uint_as_float(a & 0xffff0000u) + st.o1[4 * g4 + 1] * gs);
      o.y = pack2(__uint_as_float(bq << 16) + st.o1[4 * g4 + 2] * gs, __uint_as_float(bq & 0xffff0000u) + st.o1[4 * g4 + 3] * gs);
      *(u32x2*)(ya + 32 + 8 * g4 + 4 * h) = o;
    }
  }
}

DI void fox_item(const Params& p, int b, int hd, int qb, char* smem, int tid) {
  char* ws = p.ws;
  const int lane = tid & 63, wave = tid >> 6, r = lane & 31, h = lane >> 5;
  const int tq = qb * 256 + wave * 32 + r;
  const size_t row = (size_t)b * S + tq;
  bf16x8 qf[4];
  load_q(qf, (const u16*)(ws + A_FQ) + row * 384 + hd * 64, lane);
  const float* cum = (const float*)(ws + A_CUM) + (size_t)(b * 6 + hd) * S;
  const float cq2 = cum[tq] * LOG2E;
  AttnSt st;
  attn_init(st);
  attn_loop<0, true>(st, qf, (const u16*)(ws + A_FK) + (size_t)b * S * 384 + hd * 64, 384,
                     (const u16*)(ws + A_FVT) + (size_t)(b * 6 + hd) * 64 * S, S, cum, 0, 4 * qb + 4, tq, 0, 0ull, cq2, smem, tid);
  const float lt = st.l + __shfl_xor(st.l, 32);
  const float inv = lt > 0.f ? 1.f / lt : 0.f;
  u16* yc = (u16*)(ws + A_YC) + row * 384 + hd * 64;
#pragma unroll
  for (int g4 = 0; g4 < 4; ++g4) {
    uint2 o;
    o.x = pack2(st.o0[4 * g4] * inv, st.o0[4 * g4 + 1] * inv); o.y = pack2(st.o0[4 * g4 + 2] * inv, st.o0[4 * g4 + 3] * inv);
    *(uint2*)(yc + 8 * g4 + 4 * h) = o;
    o.x = pack2(st.o1[4 * g4] * inv, st.o1[4 * g4 + 1] * inv); o.y = pack2(st.o1[4 * g4 + 2] * inv, st.o1[4 * g4 + 3] * inv);
    *(uint2*)(yc + 32 + 8 * g4 + 4 * h) = o;
  }
}

DI void dil_item(const Params& p, int b, int hh, int res, int qblk, char* smem, int tid) {
  char* ws = p.ws;
  const int lane = tid & 63, wave = tid >> 6, r = lane & 31, h = lane >> 5;
  const int g = hh >> 1, dl = 2 * g, L = S >> dl;
  const int tq = qblk * 256 + wave * 32 + r;
  const size_t prow = (size_t)b * S + (size_t)res * L + tq;
  bf16x8 qf[4];
  load_q(qf, (const u16*)(ws + A_DQ) + prow * 384 + hh * 64, lane);
  AttnSt st;
  attn_init(st);
  const int lo = qblk * 256 - 128;
  attn_loop<1, false>(st, qf, (const u16*)(ws + A_DK) + ((size_t)b * S + (size_t)res * L) * 384 + hh * 64, 384,
                      (const u16*)(ws + A_DVT) + (size_t)(b * 6 + hh) * 64 * S + (size_t)res * L, S, nullptr, (lo > 0 ? lo : 0) >> 6,
                      4 * qblk + 4, tq, 129, 0ull, 0.f, smem, tid);
  const float lt = st.l + __shfl_xor(st.l, 32);
  const float inv = lt > 0.f ? 1.f / lt : 0.f;
  const int tnat = (tq << dl) + res;
  const size_t nrow = (size_t)b * S + tnat;
  float* dp = (float*)(ws + A_DILP) + ((size_t)g * T + nrow) * 128 + (hh & 1) * 64;
#pragma unroll
  for (int g4 = 0; g4 < 4; ++g4) {
    *(float4*)(dp + 8 * g4 + 4 * h) = make_float4(st.o0[4 * g4] * inv, st.o0[4 * g4 + 1] * inv, st.o0[4 * g4 + 2] * inv, st.o0[4 * g4 + 3] * inv);
    *(float4*)(dp + 32 + 8 * g4 + 4 * h) = make_float4(st.o1[4 * g4] * inv, st.o1[4 * g4 + 1] * inv, st.o1[4 * g4 + 2] * inv, st.o1[4 * g4 + 3] * inv);
  }
  if (h == 0) ((float*)(ws + A_DILL))[((size_t)g * T + nrow) * 2 + (hh & 1)] = st.m + __builtin_amdgcn_logf(lt);
}

DI void cmpmlp_item(const Params& p, int l, int item, char* smem, int tid) {
  const int lane = tid & 63, wave = tid >> 6, wm = wave >> 2, wn = wave & 3, h_ = lane >> 5, c_ = lane & 31;
  char* ws = p.ws;
  const int b = item >> 1, j = item & 1;
  const u16* A = (const u16*)(ws + (j ? A_VCMP : A_KCMP)) + (size_t)b * S * 64;
  const u16* W = (const u16*)(ws + OFF_WC1) + (size_t)(l * 2 + j) * 128 * 2048;
  const float* peb = (const float*)(ws + OFF_PEB) + (l * 2 + j) * 128;
  f32x16 acc[4][1];
  zero_acc<4, 1>(acc);
  gemm_first<4, 1>(A, 1024, W, 2048, smem, tid);
  gemm_k<4, 1>(acc, A, 1024, W, 2048, 32, smem, tid, false, A, 1024, W, 2048);
  u16* hc = (u16*)(ws + A_HIDC) + (size_t)(b * 2 + j) * 256 * 128;
  {
    const int h = launder_i(h_), c = launder_i(c_);
    const int col = wn * 32 + c;
    const float pb = peb[col];
#pragma unroll
    for (int mi = 0; mi < 4; ++mi)
#pragma unroll
      for (int i = 0; i < 16; ++i) {
        const int row = wm * 128 + mi * 32 + crow(i, h);
        hc[(size_t)row * 128 + col] = f2bf(siluf_(acc[mi][0][i] + pb));
      }
  }
  asm volatile("s_waitcnt vmcnt(0)" ::: "memory");
  __syncthreads();
  const u16* W2 = (const u16*)(ws + OFF_WC2) + (size_t)(l * 2 + j) * 128 * 128;
  zero_acc<4, 1>(acc);
  gemm_first<4, 1>(hc, 128, W2, 128, smem, tid);
  gemm_k<4, 1>(acc, hc, 128, W2, 128, 2, smem, tid, false, hc, 128, W2, 128);
  const int h = launder_i(h_), c = launder_i(c_);
  if (wn < 2) {
    const int d = wn * 32 + c;
#pragma unroll
    for (int mi = 0; mi < 4; ++mi)
#pragma unroll
      for (int i = 0; i < 16; ++i) {
        const int row = wm * 128 + mi * 32 + crow(i, h);
        const float v = row < 255 ? acc[mi][0][i] : 0.f;
        if (j == 0) ((u16*)(ws + A_KC))[((size_t)b * 256 + row) * 64 + d] = f2bf(v);
        else ((u16*)(ws + A_VCT))[((size_t)b * 64 + d) * 256 + row] = f2bf(v);
      }
  }
}
DI void cumsum_item(const Params& p, int item, int tid) {
  const int lane = tid & 63, wave = tid >> 6;
  char* ws = p.ws;
  const int wi = item * 8 + wave;
  const int b = wi / 6, hd = wi % 6;
  const float* fl = (const float*)(ws + A_FLOG) + (size_t)b * S * 6 + hd;
  float* cum = (float*)(ws + A_CUM) + (size_t)(b * 6 + hd) * S;
  float ssum = 0.f;
  for (int k = 0; k < 64; ++k) ssum += fl[(size_t)(lane * 64 + k) * 6];
  float incl = ssum;
  for (int o = 1; o < 64; o <<= 1) { const float v = __shfl_up(incl, o); if (lane >= o) incl += v; }
  float run = incl - ssum;
  for (int k = 0; k < 64; ++k) { run += fl[(size_t)(lane * 64 + k) * 6]; cum[lane * 64 + k] = run; }
}
DI void q_publish(unsigned* cnt, int tid) {
  asm volatile("s_waitcnt vmcnt(0)" ::: "memory");
  __syncthreads();
  if (tid == 0) {
    __builtin_amdgcn_fence(__ATOMIC_RELEASE, "agent");
    asm volatile("s_waitcnt vmcnt(0)" ::: "memory");
    __hip_atomic_fetch_add(cnt, 1u, __ATOMIC_RELAXED, __HIP_MEMORY_SCOPE_AGENT);
  }
}
DI void q_wait(unsigned* cnt, unsigned n, int tid) {
  if (tid == 0) {
    while (__hip_atomic_load(cnt, __ATOMIC_RELAXED, __HIP_MEMORY_SCOPE_AGENT) < n) __builtin_amdgcn_s_sleep(4);
    __builtin_amdgcn_fence(__ATOMIC_ACQUIRE, "agent");
    asm volatile("s_waitcnt vmcnt(0)" ::: "memory");
  }
  __syncthreads();
}
constexpr int Q_CMP = 16, Q_CUM = 6, Q_DIL = 768, Q_PRE = Q_CMP + Q_CUM + Q_DIL;
constexpr int ATT_MAIN = 16 * 80;
constexpr int ATT_TOTAL = Q_PRE + ATT_MAIN;
DI void attn_phase(const Params& p, int l, char* smem, int tid0) {
  unsigned* ctr = (unsigned*)(p.ws + OFF_CTR) + l;
  unsigned* cmp_done = (unsigned*)(p.ws + OFF_CTR) + 8 + l;
  unsigned* cum_done = (unsigned*)(p.ws + OFF_CTR) + 12 + l;
  int* ip = (int*)(smem + SM_ITEM);
  bool got_cmp = false, got_cum = false;
  int nxt_idx = 0;
  if (tid0 == 0) nxt_idx = (int)atomicAdd(ctr, 1u);
  for (;;) {
    const int tid = launder_i(tid0);
    __syncthreads();
    if (tid == 0) *ip = nxt_idx;
    __syncthreads();
    const int idx = *ip;
    if (idx >= ATT_TOTAL) break;
    if (tid == 0) nxt_idx = (int)atomicAdd(ctr, 1u);
    if (idx < Q_CMP) {
      cmpmlp_item(p, l, idx, smem, tid);
      q_publish(cmp_done, tid);
    } else if (idx < Q_CMP + Q_CUM) {
      cumsum_item(p, idx - Q_CMP, tid);
      q_publish(cum_done, tid);
    } else if (idx < Q_PRE) {
      const int e = idx - Q_CMP - Q_CUM;
      const int bh = e >> 4, sub = e & 15;
      const int b = bh / 6, hh = bh % 6, g = hh >> 1;
      const int nblk = 16 >> (2 * g);
      dil_item(p, b, hh, sub / nblk, sub % nblk, smem, tid);
    } else {
      const int m = idx - Q_PRE;
      const int k = 15 - m / 80, rr = m % 80;
      if (rr < 48) {
        if (!got_cum) { q_wait(cum_done, Q_CUM, tid); got_cum = true; }
        fox_item(p, rr / 6, rr % 6, k, smem, tid);
      } else {
        if (!got_cmp) { q_wait(cmp_done, Q_CMP, tid); got_cmp = true; }
        const int e = rr - 48;
        nsa_item(p, e & 7, 4 * k + 3 - (e >> 3), smem, tid);
      }
    }
  }
}

DI void dilcomb_phase(const Params& p, int tid) {
  char* ws = p.ws;
  const float* dp = (const float*)(ws + A_DILP);
  const float* dlse = (const float*)(ws + A_DILL);
  u16* yb = (u16*)(ws + A_YB);
  for (size_t idx = (size_t)blockIdx.x * 512 + tid; idx < (size_t)T * 32; idx += (size_t)gridDim.x * 512) {
    const size_t row = idx >> 5;
    const int c4 = (int)(idx & 31), hs = c4 >> 4;
    const float l0 = dlse[((size_t)0 * T + row) * 2 + hs], l1 = dlse[((size_t)1 * T + row) * 2 + hs], l2 = dlse[((size_t)2 * T + row) * 2 + hs];
    const float mx = fmaxf(l0, fmaxf(l1, l2));
    float w0 = __builtin_amdgcn_exp2f(l0 - mx), w1 = __builtin_amdgcn_exp2f(l1 - mx), w2 = __builtin_amdgcn_exp2f(l2 - mx);
    const float inv = 1.f / (w0 + w1 + w2);
    w0 *= inv; w1 *= inv; w2 *= inv;
    const float4 a = *(const float4*)(dp + ((size_t)0 * T + row) * 128 + c4 * 4);
    const float4 bq = *(const float4*)(dp + ((size_t)1 * T + row) * 128 + c4 * 4);
    const float4 cq = *(const float4*)(dp + ((size_t)2 * T + row) * 128 + c4 * 4);
    uint2 o;
    o.x = pack2(w0 * a.x + w1 * bq.x + w2 * cq.x, w0 * a.y + w1 * bq.y + w2 * cq.y);
    o.y = pack2(w0 * a.z + w1 * bq.z + w2 * cq.z, w0 * a.w + w1 * bq.w + w2 * cq.w);
    *(uint2*)(yb + row * 128 + c4 * 4) = o;
  }
}

DI void merge_phase(const Params& p, int l, char* smem, int tid) {
  char* ws = p.ws;
  const u16* N = (const u16*)(ws + OFF_NBUF);
  const u16* WG = (const u16*)(ws + OFF_WMIX + (size_t)l * SZ_WMIX) + (size_t)3072 * 1024;
  u16* mg = (u16*)(ws + A_MERGED);
  int mt, nt, mt2 = 0, nt2 = 0;
  bool have = tile_coords(0, 8, 4, 128 * 8, mt, nt);
  if (have) gemm_first<4, 1>(N + (size_t)mt * 256 * 1024, 1024, WG + (size_t)nt * 128 * 1024, 1024, smem, tid);
  for (int it = 0; have; ++it, mt = mt2, nt = nt2) {
    const bool have2 = tile_coords(it + 1, 8, 4, 128 * 8, mt2, nt2);
    if (!have2) { mt2 = mt; nt2 = nt; }
    have = have2;
    f32x16 macc[4];
#pragma unroll
    for (int a = 0; a < 4; ++a) macc[a] = zero16();
#pragma unroll 1
    for (int br = 0; br < 3; ++br) {
      const u16* Y = br == 0 ? (const u16*)(ws + A_YA) : br == 1 ? (const u16*)(ws + A_YB) : (const u16*)(ws + A_YC);
      const int KB = br == 0 ? 256 : br == 1 ? 128 : 384;
      const u16* WB = br == 0 ? (const u16*)(ws + OFF_WBRA) + (size_t)l * 1024 * 256
                    : br == 1 ? (const u16*)(ws + OFF_WBRB) + (size_t)l * 1024 * 128
                              : (const u16*)(ws + OFF_WBRC) + (size_t)l * 1024 * 384;
      const u16* Ay = Y + (size_t)mt * 256 * KB;
      const u16* By = WB + (size_t)nt * 128 * KB;
      f32x16 acc[4][1];
      zero_acc<4, 1>(acc);
      gemm_k<4, 1, false>(acc, N + (size_t)mt * 256 * 1024, 1024, WG + ((size_t)br * 1024 + nt * 128) * 1024, 1024, 16, smem, tid, true, Ay, KB, By, KB);
      unsigned sg[4][8];
#pragma unroll
      for (int a = 0; a < 4; ++a)
#pragma unroll
        for (int i = 0; i < 8; ++i) sg[a][i] = pack2(sigmoidf_(acc[a][0][2 * i]), sigmoidf_(acc[a][0][2 * i + 1]));
      zero_acc<4, 1>(acc);
      const bool last = (br == 2);
      const int mtn = last ? mt2 : mt, ntn = last ? nt2 : nt, brn = last ? 0 : br + 1;
      gemm_k<4, 1, false>(acc, Ay, KB, By, KB, KB / 64, smem, tid, last ? have2 : true, N + (size_t)mtn * 256 * 1024, 1024,
                   WG + ((size_t)brn * 1024 + ntn * 128) * 1024, 1024);
#pragma unroll
      for (int a = 0; a < 4; ++a)
#pragma unroll
        for (int i = 0; i < 8; ++i) {
          macc[a][2 * i] += __uint_as_float(sg[a][i] << 16) * acc[a][0][2 * i];
          macc[a][2 * i + 1] += __uint_as_float(sg[a][i] & 0xffff0000u) * acc[a][0][2 * i + 1];
        }
    }
    const int lane = tid & 63, wave = tid >> 6, wm = wave >> 2, wn = wave & 3, h = lane >> 5, c = lane & 31;
    const unsigned ebase = (unsigned)(mt * 256 + wm * 128 + 4 * h) * 1024u + (unsigned)(nt * 128 + wn * 32 + c);
#pragma unroll
    for (int mi = 0; mi < 4; ++mi)
#pragma unroll
      for (int i = 0; i < 16; ++i)
        mg[ebase + (unsigned)(mi * 32 + (i & 3) + 8 * (i >> 2)) * 1024u] = f2bf(macc[mi][i]);
  }
}

DI void final_norm_phase(const Params& p, int tid) {
  const int lane = tid & 63, wave = tid >> 6;
  for (int r = blockIdx.x * 8 + wave; r < T; r += gridDim.x * 8) {
    f32x4* src = (f32x4*)(p.out + (size_t)r * 1024);
    f32x4 v[4];
    float ss = 0.f;
#pragma unroll
    for (int j = 0; j < 4; ++j) {
      v[j] = src[lane + 64 * j];
      ss += v[j].x * v[j].x + v[j].y * v[j].y + v[j].z * v[j].z + v[j].w * v[j].w;
    }
    for (int o = 32; o; o >>= 1) ss += __shfl_xor(ss, o);
    const float rs = rsqrtf(ss * (1.f / 1024.f) + 1e-6f);
#pragma unroll
    for (int j = 0; j < 4; ++j) {
      const float4 gg = ((const float4*)p.final_g)[lane + 64 * j];
      f32x4 o4;
      o4.x = v[j].x * rs * gg.x; o4.y = v[j].y * rs * gg.y; o4.z = v[j].z * rs * gg.z; o4.w = v[j].w * rs * gg.w;
      src[lane + 64 * j] = o4;
    }
  }
}

DI int my_tid(int wave_s) { return wave_s * 64 + (int)__builtin_amdgcn_mbcnt_hi(~0u, __builtin_amdgcn_mbcnt_lo(~0u, 0u)); }
#define XB_TMO      128
#define XB_XCNT(j)  (256  + 64 * (j))
#define XB_XSUB(j)  (1280 + 64 * (j))
#define XB_XGEN(j)  (2304 + 64 * (j))
#define XB_TOP      3328
#define XB_TOPGEN   3392
#define XB_SPIN_CAP (1u << 20)
#define LAS __attribute__((address_space(3)))
DI unsigned xb_ld(unsigned* p) { return __hip_atomic_load(p, __ATOMIC_RELAXED, __HIP_MEMORY_SCOPE_AGENT); }
DI unsigned xb_add(unsigned* p, unsigned v) { return __hip_atomic_fetch_add(p, v, __ATOMIC_RELAXED, __HIP_MEMORY_SCOPE_AGENT); }
DI unsigned xb_xcc_id() { return (unsigned)__builtin_amdgcn_s_getreg((3 << 11) | 20) & 0xFu; }
#define XB_SPIN(cond, bar) do { unsigned _sp = 0; while (cond) { __builtin_amdgcn_s_sleep(1); \
    if ((++_sp & 255u) == 0u) { if (xb_ld(&(bar)[XB_TMO])) break; if (_sp > XB_SPIN_CAP) { atomicAdd(&(bar)[XB_TMO], 1u); break; } } } } while (0)
struct XcdBarrier { unsigned* bar; unsigned x; volatile LAS unsigned* st; };
DI XcdBarrier xcd_barrier_post(unsigned* bar, volatile LAS unsigned* st) {
  XcdBarrier b; b.bar = bar; b.x = xb_xcc_id(); b.st = st;
  if (threadIdx.x == 0) (void)xb_add(&bar[XB_XCNT(b.x)], 1u);
  return b;
}
DI void xcd_barrier_complete(unsigned* bar, unsigned x, unsigned& nloc, unsigned& nx) {
  const unsigned G = gridDim.x * gridDim.y * gridDim.z;
  unsigned sum, cnt, mine, sp = 0u;
  for (;;) {
    sum = 0u; cnt = 0u; mine = 0u;
#pragma unroll
    for (unsigned j = 0; j < 16; ++j) { const unsigned c = xb_ld(&bar[XB_XCNT(j)]); sum += c; cnt += (c > 0u) ? 1u : 0u; mine = (j == x) ? c : mine; }
    if (sum == G) break;
    __builtin_amdgcn_s_sleep(1);
    if ((++sp & 255u) == 0u) { if (xb_ld(&bar[XB_TMO])) break; if (sp > XB_SPIN_CAP) { atomicAdd(&bar[XB_TMO], 1u); break; } }
  }
  nloc = mine > 0u ? mine : 1u; nx = cnt > 0u ? cnt : 1u;
}
DI void xcd_barrier(const XcdBarrier& b) {
  asm volatile("s_waitcnt vmcnt(0)" ::: "memory");
  __syncthreads();
  if (threadIdx.x == 0) {
    unsigned* bar = b.bar;
    __builtin_amdgcn_s_waitcnt(0);
    unsigned nloc = b.st[0], nx = b.st[1];
    if (nloc == 0u) { xcd_barrier_complete(bar, b.x, nloc, nx); b.st[0] = nloc; b.st[1] = nx; }
    const unsigned old = xb_add(&bar[XB_XSUB(b.x)], 1u);
    const unsigned gen = old / nloc;
    if (old + 1u == (gen + 1u) * nloc) {
      __builtin_amdgcn_fence(__ATOMIC_RELEASE, "agent");
      asm volatile("s_waitcnt vmcnt(0)" ::: "memory");
      const unsigned og = xb_add(&bar[XB_TOP], 1u);
      const unsigned tg = og / nx;
      if (og + 1u == (tg + 1u) * nx) xb_add(&bar[XB_TOPGEN], 1u);
      else XB_SPIN(xb_ld(&bar[XB_TOPGEN]) == tg, bar);
      __builtin_amdgcn_fence(__ATOMIC_ACQUIRE, "agent");
      xb_add(&bar[XB_XGEN(b.x)], 1u);
      asm volatile("s_waitcnt vmcnt(0)" ::: "memory");
    } else {
      XB_SPIN(xb_ld(&bar[XB_XGEN(b.x)]) == gen, bar);
      __builtin_amdgcn_fence(__ATOMIC_ACQUIRE, "agent");
      asm volatile("s_waitcnt vmcnt(0)" ::: "memory");
    }
  }
  __syncthreads();
}
DI char* launder_p(char* v) { asm volatile("" : "+s"(v)); return v; }
#define PH(...) { const int tid = launder_i((int)threadIdx.x); Params q = p; q.ws = launder_p(p.ws); q.out = (float*)launder_p((char*)p.out); char* ws = q.ws; (void)ws; (void)tid; __VA_ARGS__; }

template <int l>
DI void layer_body(const Params& p, const XcdBarrier& xb, char* smem) {
    PH(norm_phase(q, (l == 0) ? q.x : q.out, l, 0, tid));
    xcd_barrier(xb);
    PH(ffn1_phase(q, l, 0, smem, tid));
    xcd_barrier(xb);
    PH(resid_gemm_phase(q, (const u16*)(ws + A_HID), DFF, (const u16*)(ws + OFF_WFFN_OUT + (size_t)(l * 2 + 0) * SZ_WFFN_OUT),
                        (l == 0) ? q.x : q.out, q.out, l, 2, 0.5f, smem, tid));
    xcd_barrier(xb);
    PH(norm_phase(q, q.out, l, 1, tid));
    xcd_barrier(xb);
    PH(inproj_phase(q, l, smem, tid));
    xcd_barrier(xb);
    PH(attn_phase(q, l, smem, tid));
    xcd_barrier(xb);
    PH(dilcomb_phase(q, tid));
    xcd_barrier(xb);
    PH(merge_phase(q, l, smem, tid));
    xcd_barrier(xb);
    PH(resid_gemm_phase(q, (const u16*)(ws + A_MERGED), 1024, (const u16*)(ws + OFF_WOUT) + (size_t)l * 1024 * 1024, q.out, q.out, l, 5,
                        1.0f, smem, tid));
    xcd_barrier(xb);
    PH(norm_phase(q, q.out, l, 2, tid));
    xcd_barrier(xb);
    PH(ffn1_phase(q, l, 1, smem, tid));
    xcd_barrier(xb);
    PH(resid_gemm_phase(q, (const u16*)(ws + A_HID), DFF, (const u16*)(ws + OFF_WFFN_OUT + (size_t)(l * 2 + 1) * SZ_WFFN_OUT), q.out, q.out,
                        l, 8, 0.5f, smem, tid));
    xcd_barrier(xb);
}

constexpr int DYN_LDS = 133376 + 16;
__global__ void __launch_bounds__(512, 2) mega(Params p) {
  cg::grid_group grid = cg::this_grid();
  extern __shared__ __attribute__((aligned(16))) char smem[];
  const int wave_s = __builtin_amdgcn_readfirstlane((int)(threadIdx.x >> 6));
  PH(for (int idx = blockIdx.x; idx < P0_TOTAL; idx += gridDim.x) phase0_item(q, idx, smem, tid));
  grid.sync();
  PH({
    const float* part = (const float*)(ws + OFF_MODPART);
    float* mod = (float*)(ws + OFF_MOD);
    for (int i = blockIdx.x * 512 + tid; i < 2 * 8 * 9216; i += gridDim.x * 512) {
      const int l = i / (8 * 9216), j = i % 9216;
      float a = q.ada_b[l * 9216 + j];
      for (int kc = 0; kc < 16; ++kc) a += part[(size_t)kc * (2 * 8 * 9216) + i];
      mod[i] = a;
    }
  });
  volatile LAS unsigned* xst = (volatile LAS unsigned*)(smem + 133376);
  if (threadIdx.x == 0) { xst[0] = 0u; xst[1] = 0u; }
  __syncthreads();
  const XcdBarrier xb = xcd_barrier_post((unsigned*)(p.ws + OFF_XBAR), xst);
  xcd_barrier(xb);
  layer_body<0>(p, xb, smem);
  layer_body<1>(p, xb, smem);
  PH(final_norm_phase(q, tid));
}

extern "C" void kernel_launch(void* const* d_in, const int* in_sizes, int n_in, void* d_out, int out_size, void* d_ws,
                              size_t ws_size, hipStream_t stream) {
  static int grid_blocks = 0;
  if (!grid_blocks) {
    int dev = 0, cus = 0, per_cu = 0;
    (void)hipGetDevice(&dev);
    (void)hipDeviceGetAttribute(&cus, hipDeviceAttributeMultiprocessorCount, dev);
    (void)hipFuncSetAttribute((const void*)mega, hipFuncAttributeMaxDynamicSharedMemorySize, DYN_LDS);
    (void)hipOccupancyMaxActiveBlocksPerMultiprocessor(&per_cu, mega, 512, DYN_LDS);
    if (per_cu > 1) per_cu = 1;
    if (per_cu < 1) per_cu = 1;
    grid_blocks = cus * per_cu;
  }
  Params p{};
  p.x = (const float*)d_in[0]; p.c = (const float*)d_in[1]; p.ada_w = (const float*)d_in[2]; p.ada_b = (const float*)d_in[3];
  p.norm_g = (const float*)d_in[4]; p.final_g = (const float*)d_in[5]; p.ffn_w_in = (const float*)d_in[6];
  p.ffn_w_out = (const float*)d_in[7]; p.mix_w_in = (const float*)d_in[8]; p.cmp_pe = (const float*)d_in[9];
  p.cmp_w1 = (const float*)d_in[10]; p.cmp_w2 = (const float*)d_in[11]; p.fox_bias = (const float*)d_in[12];
  p.br_nsa = (const float*)d_in[13]; p.br_dil = (const float*)d_in[14]; p.br_fox = (const float*)d_in[15];
  p.mix_w_out = (const float*)d_in[16];
  p.out = (float*)d_out; p.ws = (char*)d_ws;
  void* args[] = {&p};
  hipError_t e = hipLaunchCooperativeKernel((void*)mega, dim3(grid_blocks), dim3(512), args, DYN_LDS, stream);
  if (e != hipSuccess) fprintf(stderr, "cooperative launch failed: %s (grid %d)\n", hipGetErrorString(e), grid_blocks);
}
```

```cpp
#include <hip/hip_runtime.h>
#include <hip/hip_cooperative_groups.h>
#include <cstdio>
namespace cg = cooperative_groups;

typedef unsigned short u16;
typedef unsigned long long u64;
typedef __attribute__((ext_vector_type(8))) short bf16x8;
typedef __attribute__((ext_vector_type(4))) short bf16x4;
typedef __attribute__((ext_vector_type(16))) float f32x16;
typedef __attribute__((ext_vector_type(2))) __bf16 bf2_t;
typedef __attribute__((ext_vector_type(2))) float f2_t;
typedef __attribute__((ext_vector_type(4))) unsigned u32x4;
typedef __attribute__((ext_vector_type(2))) unsigned u32x2;
typedef __attribute__((ext_vector_type(4))) float f32x4;
#define DI __device__ __forceinline__

constexpr int S = 4096, NB = 8, T = NB * S, DM = 1024, DFF = 2816;
constexpr float LOG2E = 1.4426950408889634f;
constexpr float SC2 = 0.125f * LOG2E;

constexpr size_t SZ_WFFN_IN = (size_t)5632 * 1024 * 2;
constexpr size_t SZ_WFFN_OUT = (size_t)1024 * 2816 * 2;
constexpr size_t SZ_WMIX = (size_t)6144 * 1024 * 2;
constexpr size_t OFF_WFFN_IN = 0;
constexpr size_t OFF_WFFN_OUT = OFF_WFFN_IN + 4 * SZ_WFFN_IN;
constexpr size_t OFF_WMIX = OFF_WFFN_OUT + 4 * SZ_WFFN_OUT;
constexpr size_t OFF_WBRA = OFF_WMIX + 2 * SZ_WMIX;
constexpr size_t OFF_WBRB = OFF_WBRA + 2 * 1024 * 256 * 2;
constexpr size_t OFF_WBRC = OFF_WBRB + 2 * 1024 * 128 * 2;
constexpr size_t OFF_WOUT = OFF_WBRC + 2 * 1024 * 384 * 2;
constexpr size_t OFF_WC1 = OFF_WOUT + 2 * 1024 * 1024 * 2;
constexpr size_t OFF_WC2 = OFF_WC1 + 4 * 128 * 2048 * 2;
constexpr size_t OFF_PEB = OFF_WC2 + 4 * 128 * 128 * 2;
constexpr size_t OFF_MOD = OFF_PEB + 4 * 128 * 4;
constexpr size_t SZ_MOD = (size_t)2 * 8 * 9216 * 4;
constexpr size_t OFF_MODPART = OFF_MOD + SZ_MOD;
constexpr size_t OFF_ROPE = OFF_MODPART + 16 * SZ_MOD;
constexpr size_t OFF_CTR = OFF_ROPE + (size_t)S * 16 * 4;
constexpr size_t OFF_XBAR = OFF_CTR + 256;
constexpr size_t OFF_NBUF = OFF_XBAR + 16384;
constexpr size_t OFF_ARENA = OFF_NBUF + (size_t)T * 1024 * 2;
constexpr size_t A_QNSA = OFF_ARENA;
constexpr size_t A_KCMP = A_QNSA + (size_t)T * 256 * 2;
constexpr size_t A_VCMP = A_KCMP + (size_t)T * 64 * 2 + 4096;
constexpr size_t A_KSEL = A_VCMP + (size_t)T * 64 * 2 + 4096;
constexpr size_t A_VSELT = A_KSEL + (size_t)T * 64 * 2;
constexpr size_t A_KWIN = A_VSELT + (size_t)T * 64 * 2;
constexpr size_t A_VWINT = A_KWIN + (size_t)T * 64 * 2;
constexpr size_t A_DQ = A_VWINT + (size_t)T * 64 * 2;
constexpr size_t A_DK = A_DQ + (size_t)T * 384 * 2;
constexpr size_t A_DVT = A_DK + (size_t)T * 384 * 2;
constexpr size_t A_FQ = A_DVT + (size_t)T * 384 * 2;
constexpr size_t A_FK = A_FQ + (size_t)T * 384 * 2;
constexpr size_t A_FVT = A_FK + (size_t)T * 384 * 2;
constexpr size_t A_GNSA = A_FVT + (size_t)T * 384 * 2;
constexpr size_t A_FLOG = A_GNSA + (size_t)T * 12 * 4;
constexpr size_t A_CUM = A_FLOG + (size_t)T * 6 * 4;
constexpr size_t A_KC = A_CUM + (size_t)T * 6 * 4;
constexpr size_t A_VCT = A_KC + (size_t)NB * 256 * 64 * 2;
constexpr size_t A_HIDC = A_VCT + (size_t)NB * 256 * 64 * 2;
constexpr size_t A_YA = A_HIDC + (size_t)NB * 2 * 256 * 128 * 2;
constexpr size_t A_YB = A_YA + (size_t)T * 256 * 2;
constexpr size_t A_YC = A_YB + (size_t)T * 128 * 2;
constexpr size_t A_DILP = A_YC + (size_t)T * 384 * 2;
constexpr size_t A_DILL = A_DILP + (size_t)3 * T * 128 * 4;
constexpr size_t A_END = A_DILL + (size_t)3 * T * 2 * 4;
constexpr size_t A_HID = OFF_ARENA;
constexpr size_t A_MERGED = OFF_ARENA;
static_assert(A_END <= (size_t)512 * 1024 * 1024, "workspace overflow");
static_assert(A_MERGED + (size_t)T * 1024 * 2 <= A_GNSA, "merged aliases live data");

struct Params {
  const float *x, *c, *ada_w, *ada_b, *norm_g, *final_g, *ffn_w_in, *ffn_w_out, *mix_w_in, *cmp_pe, *cmp_w1,
      *cmp_w2, *fox_bias, *br_nsa, *br_dil, *br_fox, *mix_w_out;
  float* out;
  char* ws;
};

DI unsigned pack2(float lo, float hi) {
  f2_t v = {lo, hi};
  bf2_t r = __builtin_convertvector(v, bf2_t);
  return __builtin_bit_cast(unsigned, r);
}
DI u16 f2bf(float f) { return (u16)(pack2(f, 0.f) & 0xffffu); }
DI float sigmoidf_(float x) { return __builtin_amdgcn_rcpf(1.f + __expf(-x)); }
DI float siluf_(float x) { return x * sigmoidf_(x); }
DI int launder_i(int v) { asm volatile("" : "+v"(v)); return v; }
DI int crow(int i, int h) { return (i & 3) + 8 * (i >> 2) + 4 * h; }
DI f32x16 mfma32(bf16x8 a, bf16x8 b, f32x16 c) { return __builtin_amdgcn_mfma_f32_32x32x16_bf16(a, b, c, 0, 0, 0); }
DI f32x16 zero16() { f32x16 z; for (int i = 0; i < 16; ++i) z[i] = 0.f; return z; }

template <int MI, int NI>
DI void g_issue(const u16* A, long lda, const u16* B, long ldb, int k0, char* sA, char* sB, int tid) {
  const unsigned r0 = tid >> 3;
  const unsigned ch = (((tid & 7) ^ ((r0 >> 1) & 7)) * 8) + k0;
  const unsigned la = (unsigned)lda, lb = (unsigned)ldb;
  const int wave = tid >> 6;
#pragma unroll
  for (int i = 0; i < MI; ++i)
    __builtin_amdgcn_global_load_lds((const unsigned*)(A + ((r0 + 64 * i) * la + ch)), (unsigned*)(sA + wave * 1024 + i * 8192), 16, 0, 0);
#pragma unroll
  for (int i = 0; i < 2 * NI; ++i)
    __builtin_amdgcn_global_load_lds((const unsigned*)(B + ((r0 + 64 * i) * lb + ch)), (unsigned*)(sB + wave * 1024 + i * 8192), 16, 0, 0);
}
template <int MI, int NI>
DI void g_frag(bf16x8 (&a)[MI], bf16x8 (&b)[NI], int j, const char* sA, const char* sB, int arow, int brow, int co) {
  if (j < NI) b[j] = *(const bf16x8*)(sB + (brow + j * 32) * 128 + co);
  else a[j - NI] = *(const bf16x8*)(sA + (arow + (j - NI) * 32) * 128 + co);
}
template <int MI, int NI, bool SW = false>
DI void g_step(f32x16 (&acc)[MI][NI], const char* sA, const char* sB, int arow, int brow, int co) {
  bf16x8 a1[MI], b1[NI];
#pragma unroll
  for (int j = 0; j < MI + NI; ++j) g_frag<MI, NI>(a1, b1, j, sA, sB, arow, brow, co);
#pragma unroll
  for (int mi = 0; mi < MI; ++mi)
#pragma unroll
    for (int ni = 0; ni < NI; ++ni) acc[mi][ni] = SW ? mfma32(b1[ni], a1[mi], acc[mi][ni]) : mfma32(a1[mi], b1[ni], acc[mi][ni]);
}
template <int MI, int NI, bool DB>
DI void g_compute(f32x16 (&acc)[MI][NI], const char* sA, const char* sB, int wm, int wn, int lane) {
  const int r = lane & 31, h = lane >> 5;
  const int swz = (r >> 1) & 7;
  const int arow = wm * 32 * MI + r, brow = wn * 32 * NI + r;
  if (!DB) {
#pragma unroll
    for (int s = 0; s < 4; ++s) {
      bf16x8 a1[MI], b1[NI];
      const int co1 = (((2 * s + h) ^ swz) << 4);
#pragma unroll
      for (int j = 0; j < MI + NI; ++j) g_frag<MI, NI>(a1, b1, j, sA, sB, arow, brow, co1);
#pragma unroll
      for (int mi = 0; mi < MI; ++mi)
#pragma unroll
        for (int ni = 0; ni < NI; ++ni) acc[mi][ni] = mfma32(a1[mi], b1[ni], acc[mi][ni]);
    }
    return;
  }
  bf16x8 a[2][MI], b[2][NI];
#pragma unroll
  for (int j = 0; j < MI + NI; ++j) g_frag<MI, NI>(a[0], b[0], j, sA, sB, arow, brow, ((h ^ swz) << 4));
#pragma unroll
  for (int s = 0; s < 4; ++s) {
    const int cur = s & 1, nx = cur ^ 1;
    const int co = (((2 * (s + 1) + h) ^ swz) << 4);
#pragma unroll
    for (int mi = 0; mi < MI; ++mi)
#pragma unroll
      for (int ni = 0; ni < NI; ++ni) {
        acc[mi][ni] = mfma32(a[cur][mi], b[cur][ni], acc[mi][ni]);
        const int j = mi * NI + ni;
        if (s < 3 && j < MI + NI) g_frag<MI, NI>(a[nx], b[nx], j, sA, sB, arow, brow, co);
      }
    if (s < 3) {
#pragma unroll
      for (int j = MI * NI; j < MI + NI; ++j) g_frag<MI, NI>(a[nx], b[nx], j, sA, sB, arow, brow, co);
    }
    if (s < 3) {
#pragma unroll
      for (int j = 0; j < MI + NI && j < MI * NI; ++j) {
        __builtin_amdgcn_sched_group_barrier(0x008, 1, 0);
        __builtin_amdgcn_sched_group_barrier(0x100, 1, 0);
      }
      if (MI * NI > MI + NI) __builtin_amdgcn_sched_group_barrier(0x008, MI * NI - (MI + NI), 0);
    }
  }
}
template <int MI, int NI>
DI void gemm_first(const u16* A, long lda, const u16* B, long ldb, char* smem, int tid) {
  asm volatile("" : "+s"(A), "+s"(B));
  __syncthreads();
  g_issue<MI, NI>(A, lda, B, ldb, 0, smem, smem + 32768, tid);
  asm volatile("s_waitcnt vmcnt(0)" ::: "memory");
  __syncthreads();
}
template <int MI, int NI, bool DB = true, bool SW = false>
DI void gemm_k(f32x16 (&acc)[MI][NI], const u16* A, long lda, const u16* B, long ldb, int nkt, char* smem, int tid, bool has_next,
               const u16* nA, long nlda, const u16* nB, long nldb) {
  const int lane = tid & 63, wave = tid >> 6, wm = wave >> 2, wn = wave & 3;
  asm volatile("" : "+s"(A), "+s"(B), "+s"(nA), "+s"(nB));
  for (int kt = 0; kt < nkt; ++kt) {
    char* cur = smem + (kt & 1) * 65536;
    char* nxt = smem + ((kt & 1) ^ 1) * 65536;
    if (!DB) {
      if (kt + 1 < nkt) g_issue<MI, NI>(A, lda, B, ldb, (kt + 1) * 64, nxt, nxt + 32768, tid);
      else if (has_next) g_issue<MI, NI>(nA, nlda, nB, nldb, 0, nxt, nxt + 32768, tid);
      g_compute<MI, NI, false>(acc, cur, cur + 32768, wm, wn, lane);
      asm volatile("s_waitcnt vmcnt(0)" ::: "memory");
      __syncthreads();
      continue;
    }
    const bool late = (wave >= 4);
    const int r_ = lane & 31, h_ = lane >> 5, swz_ = (r_ >> 1) & 7;
    const int arow = wm * 32 * MI + r_, brow = wn * 32 * NI + r_;
    const char* cA = cur; const char* cB = cur + 32768;
    if (late) {
      g_step<MI, NI, SW>(acc, cA, cB, arow, brow, ((0 + h_) ^ swz_) << 4);
      g_step<MI, NI, SW>(acc, cA, cB, arow, brow, ((2 + h_) ^ swz_) << 4);
    }
    if (kt + 1 < nkt) g_issue<MI, NI>(A, lda, B, ldb, (kt + 1) * 64, nxt, nxt + 32768, tid);
    else if (has_next) g_issue<MI, NI>(nA, nlda, nB, nldb, 0, nxt, nxt + 32768, tid);
    if (!late) {
      g_step<MI, NI, SW>(acc, cA, cB, arow, brow, ((0 + h_) ^ swz_) << 4);
      g_step<MI, NI, SW>(acc, cA, cB, arow, brow, ((2 + h_) ^ swz_) << 4);
    }
    g_step<MI, NI, SW>(acc, cA, cB, arow, brow, ((4 + h_) ^ swz_) << 4);
    g_step<MI, NI, SW>(acc, cA, cB, arow, brow, ((6 + h_) ^ swz_) << 4);
    asm volatile("s_waitcnt vmcnt(0)" ::: "memory");
    __syncthreads();
  }
}
DI f32x4 mfma16(bf16x8 a, bf16x8 b, f32x4 c) { return __builtin_amdgcn_mfma_f32_16x16x32_bf16(a, b, c, 0, 0, 0); }
template <int NB>
DI void g_step16(f32x4 (&acc)[8][NB], const char* sA, const char* sB, int arow, int brow, int co) {
  bf16x8 b[NB];
#pragma unroll
  for (int nb = 0; nb < NB; ++nb) b[nb] = *(const bf16x8*)(sB + (brow + nb * 16) * 128 + co);
#pragma unroll
  for (int mb = 0; mb < 8; ++mb) {
    const bf16x8 a = *(const bf16x8*)(sA + (arow + mb * 16) * 128 + co);
#pragma unroll
    for (int nb = 0; nb < NB; ++nb) acc[mb][nb] = mfma16(a, b[nb], acc[mb][nb]);
  }
}
template <int NB>
DI void gemm_k16(f32x4 (&acc)[8][NB], const u16* A, long lda, const u16* B, long ldb, int nkt, char* smem, int tid, bool has_next,
                 const u16* nA, long nlda, const u16* nB, long nldb) {
  constexpr int NI = NB / 2;
  const int lane = tid & 63, wave = tid >> 6, wm = wave >> 2, wn = wave & 3;
  asm volatile("" : "+s"(A), "+s"(B), "+s"(nA), "+s"(nB));
  const int r_ = lane & 15, q_ = lane >> 4, swz_ = (r_ >> 1) & 7;
  const int arow = wm * 128 + r_, brow = wn * 16 * NB + r_;
  const bool late = (wave >= 4);
  for (int kt = 0; kt < nkt; ++kt) {
    char* cur = smem + (kt & 1) * 65536;
    char* nxt = smem + ((kt & 1) ^ 1) * 65536;
    const char* cA = cur; const char* cB = cur + 32768;
    if (late) g_step16(acc, cA, cB, arow, brow, ((0 + q_) ^ swz_) << 4);
    if (kt + 1 < nkt) g_issue<4, NI>(A, lda, B, ldb, (kt + 1) * 64, nxt, nxt + 32768, tid);
    else if (has_next) g_issue<4, NI>(nA, nlda, nB, nldb, 0, nxt, nxt + 32768, tid);
    if (!late) g_step16(acc, cA, cB, arow, brow, ((0 + q_) ^ swz_) << 4);
    g_step16(acc, cA, cB, arow, brow, ((4 + q_) ^ swz_) << 4);
    asm volatile("s_waitcnt vmcnt(0)" ::: "memory");
    __syncthreads();
  }
}
template <int NB>
DI void zero_acc16(f32x4 (&acc)[8][NB]) {
#pragma unroll
  for (int a = 0; a < 8; ++a)
#pragma unroll
    for (int b = 0; b < NB; ++b) acc[a][b] = (f32x4){0.f, 0.f, 0.f, 0.f};
}
template <int MI, int NI>
DI void zero_acc(f32x16 (&acc)[MI][NI]) {
#pragma unroll
  for (int a = 0; a < MI; ++a)
#pragma unroll
    for (int b = 0; b < NI; ++b) acc[a][b] = zero16();
}
DI bool tile_coords(int it, int NT, int SN, int total, int& mt, int& nt) {
  const int G = gridDim.x, b = blockIdx.x;
  int L = it * G + ((G & 7) == 0 ? ((b & 7) * (G >> 3) + (b >> 3)) : b);
  if (L >= total) return false;
  const int SM = 32 / SN, nst = NT / SN;
  const int stl = L >> 5, w = L & 31;
  const int stm = stl / nst, stn = stl - stm * nst;
  mt = stm * SM + w / SN;
  nt = stn * SN + (w % SN);
  return true;
}

template <bool VEC, class CM>
DI void conv_tile(const float* src, long ldsrc, int k0, u16* dst, long lddst, int n0, CM cm, float* sm, int tid) {
  const int r = tid >> 2, cc = (tid & 3) * 8;
  float v[8];
  const float* rowp = src + (long)(k0 + r) * ldsrc;
  if (VEC) {
    const int c0 = cm(cc);
    if (c0 >= 0) {
      float4 a = *(const float4*)(rowp + c0), b = *(const float4*)(rowp + c0 + 4);
      v[0] = a.x; v[1] = a.y; v[2] = a.z; v[3] = a.w; v[4] = b.x; v[5] = b.y; v[6] = b.z; v[7] = b.w;
    } else {
      for (int j = 0; j < 8; ++j) v[j] = 0.f;
    }
  } else {
#pragma unroll
    for (int j = 0; j < 8; ++j) { const int c = cm(cc + j); v[j] = c >= 0 ? rowp[c] : 0.f; }
  }
  __syncthreads();
#pragma unroll
  for (int j = 0; j < 8; ++j) sm[r * 33 + cc + j] = v[j];
  __syncthreads();
  const int n = tid >> 3, kc = (tid & 7) * 8;
  uint4 o;
  o.x = pack2(sm[(kc + 0) * 33 + n], sm[(kc + 1) * 33 + n]);
  o.y = pack2(sm[(kc + 2) * 33 + n], sm[(kc + 3) * 33 + n]);
  o.z = pack2(sm[(kc + 4) * 33 + n], sm[(kc + 5) * 33 + n]);
  o.w = pack2(sm[(kc + 6) * 33 + n], sm[(kc + 7) * 33 + n]);
  *(uint4*)(dst + (long)(n0 + n) * lddst + k0 + kc) = o;
}

constexpr int CV_FFN_IN = 4 * 88 * 16;
constexpr int CV_FFN_OUT = 4 * 16 * 44;
constexpr int CV_MIX = 2 * 96 * 16;
constexpr int CV_BRA = 2 * 16 * 4;
constexpr int CV_BRB = 2 * 16 * 2;
constexpr int CV_BRC = 2 * 16 * 6;
constexpr int CV_WOUT = 2 * 16 * 16;
constexpr int CV_C1 = 4 * 2 * 32;
constexpr int CV_C2 = 4 * 2 * 2;
constexpr int CV_TOTAL = CV_FFN_IN + CV_FFN_OUT + CV_MIX + CV_BRA + CV_BRB + CV_BRC + CV_WOUT + CV_C1 + CV_C2;
constexpr int P0_ADA = 144, P0_PEB = 4, P0_ROPE = 8;
constexpr int P0_TOTAL = CV_TOTAL + P0_ADA + P0_PEB + P0_ROPE;

DI void phase0_item(const Params& p, int idx, char* smem, int tid512) {
  const int half = tid512 >> 8, tid = tid512 & 255;
  float* sm = (float*)smem + half * (64 * 33);
  char* ws = p.ws;
  if (idx < P0_ADA) {
    const int lane = tid512 & 63, wave = tid512 >> 6;
    const int wi = idx * 8 + wave;
    const int l = wi / 576, rem = wi % 576, kc = rem / 36, cgp = rem % 36;
    const int col = cgp * 256 + lane * 4;
    f32x4 acc[8];
#pragma unroll
    for (int b = 0; b < 8; ++b) acc[b] = (f32x4){0.f, 0.f, 0.f, 0.f};
    for (int k0 = kc * 64; k0 < kc * 64 + 64; k0 += 8) {
      f32x4 w[8];
#pragma unroll
      for (int u = 0; u < 8; ++u) w[u] = *(const f32x4*)(p.ada_w + ((size_t)l * 1024 + k0 + u) * 9216 + col);
#pragma unroll
      for (int u = 0; u < 8; ++u)
#pragma unroll
        for (int b = 0; b < 8; ++b) {
          const float cb = siluf_(p.c[b * 1024 + k0 + u]);
          acc[b] += cb * w[u];
        }
    }
    float* part = (float*)(ws + OFF_MODPART) + (size_t)kc * (2 * 8 * 9216);
#pragma unroll
    for (int b = 0; b < 8; ++b) *(f32x4*)(part + ((size_t)l * 8 + b) * 9216 + col) = acc[b];
    return;
  }
  idx -= P0_ADA;
  if (idx < P0_PEB) {
    const int m = idx, colc = tid512 & 127, kq = tid512 >> 7;
    const float* pe = p.cmp_pe + (size_t)m * 2048;
    const float* w1 = p.cmp_w1 + (size_t)m * 2048 * 128;
    float a = 0.f;
    for (int k0 = kq * 512; k0 < kq * 512 + 512; k0 += 8) {
      float wv[8], pv8[8];
#pragma unroll
      for (int u = 0; u < 8; ++u) { wv[u] = w1[(size_t)(k0 + u) * 128 + colc]; pv8[u] = pe[k0 + u]; }
#pragma unroll
      for (int u = 0; u < 8; ++u) a += pv8[u] * wv[u];
    }
    float* smf = (float*)smem;
    __syncthreads();
    smf[tid512] = a;
    __syncthreads();
    if (tid512 < 128) ((float*)(ws + OFF_PEB))[m * 128 + tid512] = smf[tid512] + smf[tid512 + 128] + smf[tid512 + 256] + smf[tid512 + 384];
    return;
  }
  idx -= P0_PEB;
  if (idx < P0_ROPE) {
    const int t = idx * 512 + tid512;
    float* rp = (float*)(ws + OFF_ROPE) + (size_t)t * 16;
    for (int f = 0; f < 8; ++f) {
      const float inv = (float)pow(500000.0, -(double)f / 8.0);
      const float ang = (float)t * inv;
      rp[f] = (float)cos((double)ang);
      rp[8 + f] = (float)sin((double)ang);
    }
    if (idx == 0 && tid512 < 64) ((unsigned*)(ws + OFF_CTR))[tid512] = 0u;
    if (idx == 0) for (int i = tid512; i < 4096; i += 512) ((unsigned*)(ws + OFF_XBAR))[i] = 0u;
    return;
  }
  idx -= P0_ROPE;
  if (idx < CV_FFN_IN) {
    const int m = idx / (88 * 16), r = idx % (88 * 16), ng = (r / 16) * 2 + half, kt = r % 16;
    const int n0 = ng * 32;
    const int tile = n0 >> 8, within = n0 & 255, wn = within >> 6, r64 = within & 63, isup = r64 >> 5;
    const int c0 = tile * 128 + wn * 32 + (isup ? 2816 : 0);
    conv_tile<true>(p.ffn_w_in + (size_t)m * 1024 * 5632, 5632, kt * 64, (u16*)(ws + OFF_WFFN_IN + m * SZ_WFFN_IN), 1024, n0,
                    [=](int j) { return c0 + j; }, sm, tid);
    return;
  }
  idx -= CV_FFN_IN;
  if (idx < CV_FFN_OUT) {
    const int m = idx / (16 * 44), r = idx % (16 * 44), ng = (r / 44) * 2 + half, kt = r % 44;
    conv_tile<true>(p.ffn_w_out + (size_t)m * 2816 * 1024, 1024, kt * 64, (u16*)(ws + OFF_WFFN_OUT + m * SZ_WFFN_OUT), 2816,
                    ng * 32, [=](int j) { return ng * 32 + j; }, sm, tid);
    return;
  }
  idx -= CV_FFN_OUT;
  if (idx < CV_MIX) {
    const int l = idx / (96 * 16), r = idx % (96 * 16), ng = (r / 16) * 2 + half, kt = r % 16;
    const int n0 = ng * 32;
    conv_tile<false>(p.mix_w_in + (size_t)l * 1024 * 6034, 6034, kt * 64, (u16*)(ws + OFF_WMIX + l * SZ_WMIX), 1024, n0,
                     [=](int j) {
                       const int n = n0 + j;
                       if (n < 640) return n;
                       if (n < 1792) return 652 + (n - 640);
                       if (n < 2944) return 1804 + (n - 1792);
                       if (n < 3072) { const int g = n - 2944; return g < 12 ? 640 + g : (g < 18 ? 2956 + (g - 12) : -1); }
                       return 2962 + (n - 3072);
                     },
                     sm, tid);
    return;
  }
  idx -= CV_MIX;
  if (idx < CV_BRA) {
    const int l = idx / 64, r = idx % 64, ng = (r / 4) * 2 + half, kt = r % 4;
    conv_tile<true>(p.br_nsa + (size_t)l * 256 * 1024, 1024, kt * 64, (u16*)(ws + OFF_WBRA) + (size_t)l * 1024 * 256, 256, ng * 32,
                    [=](int j) { return ng * 32 + j; }, sm, tid);
    return;
  }
  idx -= CV_BRA;
  if (idx < CV_BRB) {
    const int l = idx / 32, r = idx % 32, ng = (r / 2) * 2 + half, kt = r % 2;
    conv_tile<true>(p.br_dil + (size_t)l * 128 * 1024, 1024, kt * 64, (u16*)(ws + OFF_WBRB) + (size_t)l * 1024 * 128, 128, ng * 32,
                    [=](int j) { return ng * 32 + j; }, sm, tid);
    return;
  }
  idx -= CV_BRB;
  if (idx < CV_BRC) {
    const int l = idx / 96, r = idx % 96, ng = (r / 6) * 2 + half, kt = r % 6;
    conv_tile<true>(p.br_fox + (size_t)l * 384 * 1024, 1024, kt * 64, (u16*)(ws + OFF_WBRC) + (size_t)l * 1024 * 384, 384, ng * 32,
                    [=](int j) { return ng * 32 + j; }, sm, tid);
    return;
  }
  idx -= CV_BRC;
  if (idx < CV_WOUT) {
    const int l = idx / 256, r = idx % 256, ng = (r / 16) * 2 + half, kt = r % 16;
    conv_tile<true>(p.mix_w_out + (size_t)l * 1024 * 1024, 1024, kt * 64, (u16*)(ws + OFF_WOUT) + (size_t)l * 1024 * 1024, 1024,
                    ng * 32, [=](int j) { return ng * 32 + j; }, sm, tid);
    return;
  }
  idx -= CV_WOUT;
  if (idx < CV_C1) {
    const int m = idx / 64, r = idx % 64, ng = (r / 32) * 2 + half, kt = r % 32;
    conv_tile<true>(p.cmp_w1 + (size_t)m * 2048 * 128, 128, kt * 64, (u16*)(ws + OFF_WC1) + (size_t)m * 128 * 2048, 2048, ng * 32,
                    [=](int j) { return ng * 32 + j; }, sm, tid);
    return;
  }
  idx -= CV_C1;
  if (idx < CV_C2) {
    const int m = idx / 4, r = idx % 4, ng = (r / 2) * 2 + half, kt = r % 2;
    conv_tile<true>(p.cmp_w2 + (size_t)m * 128 * 64, 64, kt * 64, (u16*)(ws + OFF_WC2) + (size_t)m * 128 * 128, 128, ng * 32,
                    [=](int j) { return ng < 2 ? ng * 32 + j : -1; }, sm, tid);
    return;
  }
  idx -= CV_C2;
}

DI void norm_phase(const Params& p, const float* hin, int l, int sub, int tid) {
  const int lane = tid & 63, wave = tid >> 6;
  const float* g = p.norm_g + ((size_t)l * 3 + sub) * 1024;
  const float* mod = (const float*)(p.ws + OFF_MOD) + (size_t)l * 8 * 9216;
  u16* nb = (u16*)(p.ws + OFF_NBUF);
  for (int r = blockIdx.x * 8 + wave; r < T; r += gridDim.x * 8) {
    const int b = r >> 12;
    const f32x4* src = (const f32x4*)(hin + (size_t)r * 1024);
    f32x4 v[4];
    float ss = 0.f;
#pragma unroll
    for (int j = 0; j < 4; ++j) {
      v[j] = src[lane + 64 * j];
      ss += v[j].x * v[j].x + v[j].y * v[j].y + v[j].z * v[j].z + v[j].w * v[j].w;
    }
    for (int o = 32; o; o >>= 1) ss += __shfl_xor(ss, o);
    const float rs = rsqrtf(ss * (1.f / 1024.f) + 1e-6f);
    const float4* sh = (const float4*)(mod + (size_t)b * 9216 + (3 * sub) * 1024);
    const float4* sc = (const float4*)(mod + (size_t)b * 9216 + (3 * sub + 1) * 1024);
#pragma unroll
    for (int j = 0; j < 4; ++j) {
      const float4 gg = ((const float4*)g)[lane + 64 * j], s4 = sh[lane + 64 * j], c4 = sc[lane + 64 * j];
      const float a = v[j].x * rs * gg.x * (1.f + c4.x) + s4.x;
      const float bq = v[j].y * rs * gg.y * (1.f + c4.y) + s4.y;
      const float cq = v[j].z * rs * gg.z * (1.f + c4.z) + s4.z;
      const float dq = v[j].w * rs * gg.w * (1.f + c4.w) + s4.w;
      uint2 o; o.x = pack2(a, bq); o.y = pack2(cq, dq);
      *(uint2*)(nb + (size_t)r * 1024 + (lane + 64 * j) * 4) = o;
    }
  }
}

DI bool ffn1_coords(int it, int& mt, int& nt) {
  const int G = gridDim.x, b = blockIdx.x;
  int L = it * G + ((G & 7) == 0 ? ((b & 7) * (G >> 3) + (b >> 3)) : b);
  if (L >= 128 * 22) return false;
  if (L < 2560) {
    const int stl = L >> 5, w = L & 31, stm = stl / 5, stn = stl - stm * 5;
    mt = stm * 8 + (w >> 2); nt = stn * 4 + (w & 3);
  } else {
    const int L2 = L - 2560, stl = L2 >> 5, w = L2 & 31;
    mt = stl * 16 + (w >> 1); nt = 20 + (w & 1);
  }
  return true;
}
DI void ffn1_phase(const Params& p, int l, int f, char* smem, int tid) {
  const u16* A = (const u16*)(p.ws + OFF_NBUF);
  const u16* W = (const u16*)(p.ws + OFF_WFFN_IN + (size_t)(l * 2 + f) * SZ_WFFN_IN);
  u16* hid = (u16*)(p.ws + A_HID);
  const int lane = tid & 63, wave = tid >> 6, wm = wave >> 2, wn = wave & 3, q_ = lane >> 4, c_ = lane & 15;
  int mt, nt, mt2 = 0, nt2 = 0;
  bool have = ffn1_coords(0, mt, nt);
  if (have) gemm_first<4, 2>(A + (size_t)mt * 256 * 1024, 1024, W + (size_t)nt * 256 * 1024, 1024, smem, tid);
  for (int it = 0; have; ++it, mt = mt2, nt = nt2) {
    const bool have2 = ffn1_coords(it + 1, mt2, nt2);
    if (!have2) { mt2 = mt; nt2 = nt; }
    have = have2;
    f32x4 acc[8][4];
    zero_acc16(acc);
    gemm_k16(acc, A + (size_t)mt * 256 * 1024, 1024, W + (size_t)nt * 256 * 1024, 1024, 16, smem, tid, have2,
             A + (size_t)mt2 * 256 * 1024, 1024, W + (size_t)nt2 * 256 * 1024, 1024);
    const int q = launder_i(q_), c = launder_i(c_);
    const unsigned ebase = (unsigned)(mt * 256 + wm * 128 + 4 * q) * (unsigned)DFF + (unsigned)(nt * 128 + wn * 32 + c);
#pragma unroll
    for (int mb = 0; mb < 8; ++mb)
#pragma unroll
      for (int nb = 0; nb < 2; ++nb)
#pragma unroll
        for (int i = 0; i < 4; ++i)
          hid[ebase + (unsigned)(mb * 16 + i) * (unsigned)DFF + (unsigned)(nb * 16)] = f2bf(siluf_(acc[mb][nb][i]) * acc[mb][nb + 2][i]);
  }
}

DI void resid_gemm_phase(const Params& p, const u16* A, int K, const u16* W, const float* hin, float* hout, int l, int gachunk,
                         float scale, char* smem, int tid) {
  const int lane = tid & 63, wave = tid >> 6, wm = wave >> 2, wn = wave & 3, h_ = lane >> 5, c_ = lane & 31;
  const float* mod = (const float*)(p.ws + OFF_MOD) + (size_t)l * 8 * 9216 + gachunk * 1024;
  int mt, nt, mt2 = 0, nt2 = 0;
  bool have = tile_coords(0, 4, 4, 128 * 4, mt, nt);
  if (have) gemm_first<4, 2>(A + (size_t)mt * 256 * K, K, W + (size_t)nt * 256 * K, K, smem, tid);
  for (int it = 0; have; ++it, mt = mt2, nt = nt2) {
    const bool have2 = tile_coords(it + 1, 4, 4, 128 * 4, mt2, nt2);
    if (!have2) { mt2 = mt; nt2 = nt; }
    have = have2;
    f32x16 acc[4][2];
    zero_acc<4, 2>(acc);
    gemm_k<4, 2>(acc, A + (size_t)mt * 256 * K, K, W + (size_t)nt * 256 * K, K, K / 64, smem, tid, have2,
                 A + (size_t)mt2 * 256 * K, K, W + (size_t)nt2 * 256 * K, K);
    const int h = launder_i(h_), c = launder_i(c_);
    const int b = (mt * 256) >> 12;
#pragma unroll
    for (int ni = 0; ni < 2; ++ni) {
      const int col = nt * 256 + wn * 64 + ni * 32 + c;
      const float ga = mod[(size_t)b * 9216 + col] * scale;
      const unsigned ebase = (unsigned)(mt * 256 + wm * 128 + 4 * h) * 1024u + (unsigned)col;
#pragma unroll
      for (int mi = 0; mi < 4; ++mi) {
#pragma unroll
        for (int i = 0; i < 16; ++i) {
          const unsigned eo = ebase + (unsigned)(mi * 32 + (i & 3) + 8 * (i >> 2)) * 1024u;
          hout[eo] = hin[eo] + ga * acc[mi][ni][i];
        }
        __builtin_amdgcn_sched_barrier(0);
      }
    }
  }
}

DI void inproj_phase(const Params& p, int l, char* smem, int tid) {
  const u16* A = (const u16*)(p.ws + OFF_NBUF);
  const u16* W = (const u16*)(p.ws + OFF_WMIX + (size_t)l * SZ_WMIX);
  const float* rope = (const float*)(p.ws + OFF_ROPE);
  char* ws = p.ws;
  const int lane = tid & 63, wave = tid >> 6, wm = wave >> 2, wn = wave & 3, h_ = lane >> 5, c_ = lane & 31;
  int mt, nt, mt2 = 0, nt2 = 0;
  bool have = tile_coords(0, 12, 4, 128 * 12, mt, nt);
  if (have) gemm_first<4, 2>(A + (size_t)mt * 256 * 1024, 1024, W + (size_t)nt * 256 * 1024, 1024, smem, tid);
  for (int it = 0; have; ++it, mt = mt2, nt = nt2) {
    const bool have2 = tile_coords(it + 1, 12, 4, 128 * 12, mt2, nt2);
    if (!have2) { mt2 = mt; nt2 = nt; }
    have = have2;
    f32x16 acc[4][2];
    zero_acc<4, 2>(acc);
    gemm_k<4, 2, true, true>(acc, A + (size_t)mt * 256 * 1024, 1024, W + (size_t)nt * 256 * 1024, 1024, 16, smem, tid, have2,
                             A + (size_t)mt2 * 256 * 1024, 1024, W + (size_t)nt2 * 256 * 1024, 1024);
    const int h = launder_i(h_), c = launder_i(c_);
    const int hidx = nt * 4 + wn;
    const int rowbase = mt * 256 + wm * 128;
    const int b = rowbase >> 12;
    if (hidx == 47) continue;
    if (hidx == 46) {
#pragma unroll
      for (int mi = 0; mi < 4; ++mi) {
        const size_t row = (size_t)rowbase + mi * 32 + c;
#pragma unroll
        for (int i = 0; i < 12; ++i) {
          const int d = (i & 3) + 8 * (i >> 2) + 4 * h;
          const float v = acc[mi][0][i];
          if (d < 12) {
            ((float*)(ws + A_GNSA))[row * 12 + d] = v;
          } else if (d < 18) {
            const float xx = v + p.fox_bias[l * 6 + (d - 12)];
            ((float*)(ws + A_FLOG))[row * 6 + (d - 12)] = fminf(xx, 0.f) - log1pf(__expf(-fabsf(xx)));
          }
        }
        __builtin_amdgcn_sched_barrier(0);
      }
      continue;
    }
    bool do_rope, transposed;
    int pg = 0;
    u16* dst;
    int ld = 64, col0 = 0, nh = 1, hh = 0;
    if (hidx < 4) { dst = (u16*)(ws + A_QNSA); ld = 256; col0 = hidx * 64; do_rope = true; transposed = false; }
    else if (hidx < 10) {
      const int k = hidx - 4;
      dst = (u16*)(ws + (k == 0 ? A_KCMP : k == 1 ? A_VCMP : k == 2 ? A_KSEL : k == 3 ? A_VSELT : k == 4 ? A_KWIN : A_VWINT));
      do_rope = (k & 1) == 0; transposed = (k == 3 || k == 5);
    } else if (hidx < 28) {
      const int k = hidx - 10, which = k / 6; hh = k % 6; pg = hh >> 1; nh = 6;
      if (which == 0) { dst = (u16*)(ws + A_DQ); ld = 384; col0 = hh * 64; do_rope = true; transposed = false; }
      else if (which == 1) { dst = (u16*)(ws + A_DK); ld = 384; col0 = hh * 64; do_rope = true; transposed = false; }
      else { dst = (u16*)(ws + A_DVT); do_rope = false; transposed = true; }
    } else {
      const int k = hidx - 28, which = k / 6; hh = k % 6; nh = 6;
      do_rope = false;
      if (which == 0) { dst = (u16*)(ws + A_FQ); ld = 384; col0 = hh * 64; transposed = false; }
      else if (which == 1) { dst = (u16*)(ws + A_FK); ld = 384; col0 = hh * 64; transposed = false; }
      else { dst = (u16*)(ws + A_FVT); transposed = true; }
    }
    const int dl = pg * 2;
#pragma unroll
    for (int mi = 0; mi < 4; ++mi) {
      __builtin_amdgcn_sched_barrier(0);
      const int t = (rowbase + mi * 32 + c) & (S - 1);
      const int pidx = ((t & ((1 << dl) - 1)) << (12 - dl)) + (t >> dl);
      if (do_rope) {
        const f32x4 cs = *(const f32x4*)(rope + t * 16 + 4 * h), sn = *(const f32x4*)(rope + t * 16 + 8 + 4 * h);
#pragma unroll
        for (int i = 0; i < 4; ++i) {
          const float x1 = acc[mi][0][i], x2 = acc[mi][0][i + 4];
          const float cc = i == 0 ? cs.x : i == 1 ? cs.y : i == 2 ? cs.z : cs.w;
          const float ss = i == 0 ? sn.x : i == 1 ? sn.y : i == 2 ? sn.z : sn.w;
          acc[mi][0][i] = x1 * cc - x2 * ss;
          acc[mi][0][i + 4] = x2 * cc + x1 * ss;
        }
      }
      if (!transposed) {
        const unsigned obase = (unsigned)(b * S + pidx) * (unsigned)ld + (unsigned)(col0 + 4 * h);
#pragma unroll
        for (int ni = 0; ni < 2; ++ni) {
#pragma unroll
          for (int g4 = 0; g4 < 4; ++g4) {
            u32x2 o;
            o.x = pack2(acc[mi][ni][4 * g4 + 0], acc[mi][ni][4 * g4 + 1]);
            o.y = pack2(acc[mi][ni][4 * g4 + 2], acc[mi][ni][4 * g4 + 3]);
            *(u32x2*)(dst + (obase + (unsigned)(ni * 32 + 8 * g4))) = o;
          }
          __builtin_amdgcn_sched_barrier(0);
        }
      } else {
        const unsigned obase = (unsigned)((b * nh + hh) * 64 + 4 * h) * (unsigned)S + (unsigned)pidx;
#pragma unroll
        for (int ni = 0; ni < 2; ++ni) {
#pragma unroll
          for (int i = 0; i < 16; ++i)
            dst[obase + (unsigned)(ni * 32 + (i & 3) + 8 * (i >> 2)) * (unsigned)S] = f2bf(acc[mi][ni][i]);
          __builtin_amdgcn_sched_barrier(0);
        }
      }
    }
  }
}

DI void cmp1_phase(const Params& p, int l, char* smem, int tid) {
  const int lane = tid & 63, wave = tid >> 6, wm = wave >> 2, wn = wave & 3, h_ = lane >> 5, c_ = lane & 31;
  char* ws = p.ws;
  for (int item = blockIdx.x; item < 16 + 6; item += gridDim.x) {
    if (item < 16) {
      const int b = item >> 1, j = item & 1;
      const u16* A = (const u16*)(ws + (j ? A_VCMP : A_KCMP)) + (size_t)b * S * 64;
      const u16* W = (const u16*)(ws + OFF_WC1) + (size_t)(l * 2 + j) * 128 * 2048;
      const float* peb = (const float*)(ws + OFF_PEB) + (l * 2 + j) * 128;
      f32x16 acc[4][1];
      zero_acc<4, 1>(acc);
      gemm_first<4, 1>(A, 1024, W, 2048, smem, tid);
      gemm_k<4, 1>(acc, A, 1024, W, 2048, 32, smem, tid, false, A, 1024, W, 2048);
      const int h = launder_i(h_), c = launder_i(c_);
      u16* hc = (u16*)(ws + A_HIDC) + (size_t)(b * 2 + j) * 256 * 128;
      const int col = wn * 32 + c;
      const float pb = peb[col];
#pragma unroll
      for (int mi = 0; mi < 4; ++mi)
#pragma unroll
        for (int i = 0; i < 16; ++i) {
          const int row = wm * 128 + mi * 32 + crow(i, h);
          hc[(size_t)row * 128 + col] = f2bf(siluf_(acc[mi][0][i] + pb));
        }
    } else {
      const int wi = (item - 16) * 8 + wave;
      const int b = wi / 6, hd = wi % 6;
      const float* fl = (const float*)(ws + A_FLOG) + (size_t)b * S * 6 + hd;
      float* cum = (float*)(ws + A_CUM) + (size_t)(b * 6 + hd) * S;
      float ssum = 0.f;
      for (int k = 0; k < 64; ++k) ssum += fl[(size_t)(lane * 64 + k) * 6];
      float incl = ssum;
      for (int o = 1; o < 64; o <<= 1) { const float v = __shfl_up(incl, o); if (lane >= o) incl += v; }
      float run = incl - ssum;
      for (int k = 0; k < 64; ++k) { run += fl[(size_t)(lane * 64 + k) * 6]; cum[lane * 64 + k] = run; }
    }
  }
}
DI void cmp2_phase(const Params& p, int l, char* smem, int tid) {
  const int lane = tid & 63, wave = tid >> 6, wm = wave >> 2, wn = wave & 3, h_ = lane >> 5, c_ = lane & 31;
  char* ws = p.ws;
  for (int item = blockIdx.x; item < 16; item += gridDim.x) {
    const int b = item >> 1, j = item & 1;
    const u16* A = (const u16*)(ws + A_HIDC) + (size_t)(b * 2 + j) * 256 * 128;
    const u16* W = (const u16*)(ws + OFF_WC2) + (size_t)(l * 2 + j) * 128 * 128;
    f32x16 acc[4][1];
    zero_acc<4, 1>(acc);
    gemm_first<4, 1>(A, 128, W, 128, smem, tid);
    gemm_k<4, 1>(acc, A, 128, W, 128, 2, smem, tid, false, A, 128, W, 128);
    const int h = launder_i(h_), c = launder_i(c_);
    if (wn < 2) {
      const int d = wn * 32 + c;
#pragma unroll
      for (int mi = 0; mi < 4; ++mi)
#pragma unroll
        for (int i = 0; i < 16; ++i) {
          const int row = wm * 128 + mi * 32 + crow(i, h);
          const float v = row < 255 ? acc[mi][0][i] : 0.f;
          if (j == 0) ((u16*)(ws + A_KC))[((size_t)b * 256 + row) * 64 + d] = f2bf(v);
          else ((u16*)(ws + A_VCT))[((size_t)b * 64 + d) * 256 + row] = f2bf(v);
        }
    }
  }
}

constexpr int SM_K = 0;
constexpr int SM_V = 16384;
constexpr int SM_KB = 33792;
constexpr int SM_IMP = 34304;
constexpr int SM_SEL = 99840;
constexpr int SM_ITEM = 100352;
constexpr int SM_YP = 100608;

struct AttnSt { f32x16 o0, o1; float m, l; };
DI void attn_init(AttnSt& st) { st.o0 = zero16(); st.o1 = zero16(); st.m = -1e30f; st.l = 0.f; }

struct KVStage { u32x4 k, v; float kb; };
template <bool BIAS, bool LOADV>
DI void kv_load(KVStage& s, const u16* Kg, long ldk, const u16* Vt, long ldv, const float* kb, int key0, int tid) {
  const unsigned ch = (tid & 7) * 8, r0 = tid >> 3;
  const unsigned lk = (unsigned)ldk, lv = (unsigned)ldv;
  s.k = *(const u32x4*)(Kg + ((key0 + r0) * lk + ch));
  if (LOADV) s.v = *(const u32x4*)(Vt + (r0 * lv + key0 + ch));
  if (BIAS) { if (tid < 64) s.kb = kb[key0 + tid] * LOG2E; }
}
template <bool BIAS, bool LOADV>
DI void kv_store(const KVStage& s, char* smem, int buf, int tid) {
  const int r0 = tid >> 3, chn = tid & 7;
  const int sw = ((chn ^ ((r0 >> 1) & 7)) << 4);
  *(u32x4*)(smem + SM_K + buf * 8192 + r0 * 128 + sw) = s.k;
  if (LOADV) {
    char* vp = smem + SM_V + buf * 8704 + r0 * 136 + chn * 16;
    *(u32x2*)(vp) = s.v.xy;
    *(u32x2*)(vp + 8) = s.v.zw;
  }
  if (BIAS) { if (tid < 64) ((float*)(smem + SM_KB + buf * 256))[tid] = s.kb; }
}
DI void st_compute(f32x16 (&sacc)[2], const bf16x8 (&qf)[4], const char* kbuf, int lane) {
  const int r = lane & 31, h = lane >> 5, swz = (r >> 1) & 7;
#pragma unroll
  for (int u = 0; u < 2; ++u) {
    sacc[u] = zero16();
#pragma unroll
    for (int s = 0; s < 4; ++s) {
      const bf16x8 kf = *(const bf16x8*)(kbuf + (32 * u + r) * 128 + (((2 * s + h) ^ swz) << 4));
      sacc[u] = mfma32(kf, qf[s], sacc[u]);
    }
  }
}
template <int MODE>
DI bool key_ok(int key, int tq, int W, u64 selm, int kt) {
  if (MODE == 0) return key <= tq;
  if (MODE == 1) return key <= tq && key > tq - W;
  if (MODE == 2) return ((selm >> kt) & 1ull) && key <= tq;
  return 16 * key + 31 <= tq;
}
template <int MODE, bool BIAS>
DI void attn_loop(AttnSt& st, const bf16x8 (&qf)[4], const u16* Kg, long ldk, const u16* Vt, long ldv, const float* kb, int kt0,
                  int kt1, int tq, int W, u64 selm, float cq2, char* smem, int tid) {
  if (kt0 >= kt1) return;
  const int lane = tid & 63, r = lane & 31, h = lane >> 5;
  const int tq_min = __builtin_amdgcn_readfirstlane(tq - r), tq_max = tq_min + 31;
  KVStage kv;
  kv_load<BIAS, true>(kv, Kg, ldk, Vt, ldv, kb, kt0 * 64, tid);
  __syncthreads();
  kv_store<BIAS, true>(kv, smem, 0, tid);
  __syncthreads();
  for (int kt = kt0; kt < kt1; ++kt) {
    const int buf = (kt - kt0) & 1;
    if (kt + 1 < kt1) kv_load<BIAS, true>(kv, Kg, ldk, Vt, ldv, kb, (kt + 1) * 64, tid);
    const int key0 = kt * 64;
    bool active;
    if (MODE == 3) active = (16 * key0 + 31 <= tq_max);
    else if (MODE == 1) active = (key0 <= tq_max) && (key0 + 63 > tq_min - W);
    else active = (key0 <= tq_max);
    if (active) {
      f32x16 sacc[2];
      st_compute(sacc, qf, smem + SM_K + buf * 8192, lane);
      const float* kbs = (const float*)(smem + SM_KB + buf * 256);
      bool full;
      if (MODE == 3) full = (16 * (key0 + 63) + 31 <= tq_min);
      else if (MODE == 1) full = (key0 + 63 <= tq_min) && (key0 > tq_max - W);
      else full = (key0 + 63 <= tq_min);
      float alpha, rs = 0.f;
      if (full) {
        const bool lsel = (MODE == 2) ? (((selm >> kt) & 1ull) != 0ull) : true;
        float mx = -3e38f;
#pragma unroll
        for (int u = 0; u < 2; ++u)
#pragma unroll
          for (int g4 = 0; g4 < 4; ++g4) {
            f32x4 kb4 = {0.f, 0.f, 0.f, 0.f};
            if (BIAS) kb4 = *(const f32x4*)(kbs + 32 * u + 8 * g4 + 4 * h);
#pragma unroll
            for (int e2 = 0; e2 < 4; ++e2) {
              const int i = 4 * g4 + e2;
              if (BIAS) sacc[u][i] = __builtin_fmaf(sacc[u][i], SC2, -(e2 == 0 ? kb4.x : e2 == 1 ? kb4.y : e2 == 2 ? kb4.z : kb4.w));
              mx = fmaxf(mx, sacc[u][i]);
            }
          }
        if (!BIAS) mx *= SC2;
        if (MODE == 2) mx = lsel ? mx : -1e30f;
        mx = fmaxf(mx, __shfl_xor(mx, 32));
        const float mnew = fmaxf(st.m, mx);
        alpha = __builtin_amdgcn_exp2f(st.m - mnew);
        st.m = mnew;
#pragma unroll
        for (int u = 0; u < 2; ++u)
#pragma unroll
          for (int i = 0; i < 16; ++i) {
            float pv = BIAS ? __builtin_amdgcn_exp2f(sacc[u][i] - mnew) : __builtin_amdgcn_exp2f(__builtin_fmaf(sacc[u][i], SC2, -mnew));
            if (MODE == 2) pv = lsel ? pv : 0.f;
            rs += pv;
            sacc[u][i] = pv;
          }
      } else {
        float mx = -1e30f;
#pragma unroll
        for (int u = 0; u < 2; ++u)
#pragma unroll
          for (int g4 = 0; g4 < 4; ++g4) {
            f32x4 kb4 = {0.f, 0.f, 0.f, 0.f};
            if (BIAS) kb4 = *(const f32x4*)(kbs + 32 * u + 8 * g4 + 4 * h);
#pragma unroll
            for (int e2 = 0; e2 < 4; ++e2) {
              const int i = 4 * g4 + e2;
              const int key = key0 + 32 * u + 8 * g4 + 4 * h + e2;
              float s2 = sacc[u][i] * SC2;
              if (BIAS) s2 -= (e2 == 0 ? kb4.x : e2 == 1 ? kb4.y : e2 == 2 ? kb4.z : kb4.w);
              s2 = key_ok<MODE>(key, tq, W, selm, kt) ? s2 : -1e30f;
              sacc[u][i] = s2;
              mx = fmaxf(mx, s2);
            }
          }
        mx = fmaxf(mx, __shfl_xor(mx, 32));
        const float mnew = fmaxf(st.m, mx);
        alpha = __builtin_amdgcn_exp2f(st.m - mnew);
        st.m = mnew;
#pragma unroll
        for (int u = 0; u < 2; ++u)
#pragma unroll
          for (int i = 0; i < 16; ++i) {
            const float s2 = sacc[u][i];
            const float pv = (s2 <= -1e29f) ? 0.f : __builtin_amdgcn_exp2f(s2 - mnew);
            rs += pv;
            sacc[u][i] = pv;
          }
      }
      st.l = st.l * alpha + rs;
#pragma unroll
      for (int i = 0; i < 16; ++i) { st.o0[i] *= alpha; st.o1[i] *= alpha; }
      const char* vbuf = smem + SM_V + buf * 8704;
#pragma unroll
      for (int u = 0; u < 2; ++u)
#pragma unroll
        for (int s2i = 0; s2i < 2; ++s2i) {
          unsigned pk[4];
#pragma unroll
          for (int j = 0; j < 4; ++j) pk[j] = pack2(sacc[u][8 * s2i + 2 * j], sacc[u][8 * s2i + 2 * j + 1]);
          const u32x4 pk4 = {pk[0], pk[1], pk[2], pk[3]};
          const bf16x8 pf = __builtin_bit_cast(bf16x8, pk4);
          const int koff = (32 * u + 16 * s2i + 4 * h) * 2;
          {
            const char* vp = vbuf + r * 136 + koff;
            const u32x2 lo = *(const u32x2*)vp, hi = *(const u32x2*)(vp + 16);
            const u32x4 v4 = {lo.x, lo.y, hi.x, hi.y};
            const bf16x8 vf = __builtin_bit_cast(bf16x8, v4);
            st.o0 = mfma32(vf, pf, st.o0);
          }
          {
            const char* vp = vbuf + (32 + r) * 136 + koff;
            const u32x2 lo = *(const u32x2*)vp, hi = *(const u32x2*)(vp + 16);
            const u32x4 v4 = {lo.x, lo.y, hi.x, hi.y};
            const bf16x8 vf = __builtin_bit_cast(bf16x8, v4);
            st.o1 = mfma32(vf, pf, st.o1);
          }
        }
    }
    if (kt + 1 < kt1) kv_store<BIAS, true>(kv, smem, buf ^ 1, tid);
    __syncthreads();
  }
}
DI void load_q(bf16x8 (&qf)[4], const u16* qrow, int lane) {
  const int h = lane >> 5;
#pragma unroll
  for (int s = 0; s < 4; ++s) qf[s] = *(const bf16x8*)(qrow + 16 * s + 8 * h);
}

DI void nsa_item(const Params& p, int b, int qt, char* smem, int tid) {
  char* ws = p.ws;
  const int lane = tid & 63, wave = tid >> 6, head = wave & 3, qh = wave >> 2, r = lane & 31, h = lane >> 5;
  const int q0 = qt * 64, tq = q0 + 32 * qh + r, ql = 32 * qh + r;
  const size_t row = (size_t)b * S + tq;
  bf16x8 qf[4];
  load_q(qf, (const u16*)(ws + A_QNSA) + row * 256 + head * 64, lane);
  float* imp = (float*)(smem + SM_IMP);
  u64* selp = (u64*)(smem + SM_SEL);
  __syncthreads();
  for (int i = tid; i < 4 * 64 * 64; i += 512) imp[i] = 0.f;
  const float* gl = (const float*)(ws + A_GNSA) + row * 12 + head * 3;
  const float g0 = sigmoidf_(gl[0]), g1 = sigmoidf_(gl[1]), g2 = sigmoidf_(gl[2]);
  unsigned* yp = (unsigned*)(smem + SM_YP) + wave * 16 * 64 + lane;
  const u16* KC = (const u16*)(ws + A_KC) + (size_t)b * 256 * 64;
  const u16* VCT = (const u16*)(ws + A_VCT) + (size_t)b * 64 * 256;
  const int ktc = ((q0 + 32) >> 10) + 1;
  AttnSt st;
  attn_init(st);
  attn_loop<3, false>(st, qf, KC, 64, VCT, 256, nullptr, 0, ktc, tq, 0, 0ull, 0.f, smem, tid);
  {
    float lt = st.l + __shfl_xor(st.l, 32);
    const float inv = lt > 0.f ? 1.f / lt : 0.f;
    const float gs = g0 * inv;
#pragma unroll
    for (int i = 0; i < 8; ++i) {
      yp[i * 64] = pack2(st.o0[2 * i] * gs, st.o0[2 * i + 1] * gs);
      yp[(8 + i) * 64] = pack2(st.o1[2 * i] * gs, st.o1[2 * i + 1] * gs);
    }
    for (int kt = 0; kt < ktc; ++kt) {
      KVStage kv;
      kv_load<false, false>(kv, KC, 64, VCT, 256, nullptr, kt * 64, tid);
      __syncthreads();
      kv_store<false, false>(kv, smem, 0, tid);
      __syncthreads();
      f32x16 sacc[2];
      st_compute(sacc, qf, smem + SM_K, lane);
#pragma unroll
      for (int u = 0; u < 2; ++u)
#pragma unroll
        for (int g4 = 0; g4 < 4; ++g4) {
          float pv[4];
#pragma unroll
          for (int e = 0; e < 4; ++e) {
            const int key = kt * 64 + 32 * u + 8 * g4 + 4 * h + e;
            const float s2 = sacc[u][4 * g4 + e] * SC2;
            pv[e] = (16 * key + 31 <= tq) ? __builtin_amdgcn_exp2f(s2 - st.m) * inv : 0.f;
          }
          const int j = kt * 16 + 8 * u + 2 * g4 + h;
          atomicAdd(&imp[(head * 64 + ql) * 64 + j], pv[0] + pv[1] + pv[2] + 0.5f * pv[3]);
          if (j + 1 < 64) atomicAdd(&imp[(head * 64 + ql) * 64 + j + 1], 0.5f * pv[3]);
        }
    }
  }
  __syncthreads();
  for (int qi = 0; qi < 8; ++qi) {
    const int q = wave * 8 + qi, t = q0 + q, cur = t >> 6, j = lane;
    const float v = (imp[q * 64 + j] + imp[(64 + q) * 64 + j]) + (imp[(128 + q) * 64 + j] + imp[(192 + q) * 64 + j]);
    const float val = (j == cur || j == 0) ? 1e4f : (j <= cur ? v : -1.f);
    int rank = 0;
#pragma unroll
    for (int jj = 0; jj < 64; ++jj) {
      const float o = __int_as_float(__builtin_amdgcn_readlane(__float_as_int(val), jj));
      rank += (o > val || (o == val && jj < j)) ? 1 : 0;
    }
    const u64 mask = __ballot(rank < 16);
    if (lane == 0) selp[q] = mask;
  }
  __syncthreads();
  const u64 selm = selp[ql];
  attn_init(st);
  attn_loop<2, false>(st, qf, (const u16*)(ws + A_KSEL) + (size_t)b * S * 64, 64, (const u16*)(ws + A_VSELT) + (size_t)b * 64 * S, S,
                      nullptr, 0, ((q0 + 63) >> 6) + 1, tq, 0, selm, 0.f, smem, tid);
  {
    float lt = st.l + __shfl_xor(st.l, 32);
    const float gs = lt > 0.f ? g1 / lt : 0.f;
#pragma unroll
    for (int i = 0; i < 8; ++i) {
      const unsigned a = yp[i * 64], bq = yp[(8 + i) * 64];
      yp[i * 64] = pack2(__uint_as_float(a << 16) + st.o0[2 * i] * gs, __uint_as_float(a & 0xffff0000u) + st.o0[2 * i + 1] * gs);
      yp[(8 + i) * 64] = pack2(__uint_as_float(bq << 16) + st.o1[2 * i] * gs, __uint_as_float(bq & 0xffff0000u) + st.o1[2 * i + 1] * gs);
    }
  }
  attn_init(st);
  {
    const int lo = q0 - 511;
    attn_loop<1, false>(st, qf, (const u16*)(ws + A_KWIN) + (size_t)b * S * 64, 64, (const u16*)(ws + A_VWINT) + (size_t)b * 64 * S, S,
                        nullptr, (lo > 0 ? lo : 0) >> 6, ((q0 + 63) >> 6) + 1, tq, 512, 0ull, 0.f, smem, tid);
    float lt = st.l + __shfl_xor(st.l, 32);
    const float gs = lt > 0.f ? g2 / lt : 0.f;
    u16* ya = (u16*)(ws + A_YA) + row * 256 + head * 64;
#pragma unroll
    for (int g4 = 0; g4 < 4; ++g4) {
      u32x2 o;
      unsigned a = yp[(2 * g4) * 64], bq = yp[(2 * g4 + 1) * 64];
      o.x = pack2(__uint_as_float(a << 16) + st.o0[4 * g4] * gs, __uint_as_float(a & 0xffff0000u) + st.o0[4 * g4 + 1] * gs);
      o.y = pack2(__uint_as_float(bq << 16) + st.o0[4 * g4 + 2] * gs, __uint_as_float(bq & 0xffff0000u) + st.o0[4 * g4 + 3] * gs);
      *(u32x2*)(ya + 8 * g4 + 4 * h) = o;
      a = yp[(8 + 2 * g4) * 64]; bq = yp[(8 + 2 * g4 + 1) * 64];
      o.x = pack2(__uint_as_float(a << 16) + st.o1[4 * g4] * gs, __uint_as_float(a & 0xffff0000u) + st.o1[4 * g4 + 1] * gs);
      o.y = pack2(__uint_as_float(bq << 16) + st.o1[4 * g4 + 2] * gs, __uint_as_float(bq & 0xffff0000u) + st.o1[4 * g4 + 3] * gs);
      *(u32x2*)(ya + 32 + 8 * g4 + 4 * h) = o;
    }
  }
}

DI void fox_item(const Params& p, int b, int hd, int qb, char* smem, int tid) {
  char* ws = p.ws;
  const int lane = tid & 63, wave = tid >> 6, r = lane & 31, h = lane >> 5;
  const int tq = qb * 256 + wave * 32 + r;
  const size_t row = (size_t)b * S + tq;
  bf16x8 qf[4];
  load_q(qf, (const u16*)(ws + A_FQ) + row * 384 + hd * 64, lane);
  const float* cum = (const float*)(ws + A_CUM) + (size_t)(b * 6 + hd) * S;
  const float cq2 = cum[tq] * LOG2E;
  AttnSt st;
  attn_init(st);
  attn_loop<0, true>(st, qf, (const u16*)(ws + A_FK) + (size_t)b * S * 384 + hd * 64, 384,
                     (const u16*)(ws + A_FVT) + (size_t)(b * 6 + hd) * 64 * S, S, cum, 0, 4 * qb + 4, tq, 0, 0ull, cq2, smem, tid);
  const float lt = st.l + __shfl_xor(st.l, 32);
  const float inv = lt > 0.f ? 1.f / lt : 0.f;
  u16* yc = (u16*)(ws + A_YC) + row * 384 + hd * 64;
#pragma unroll
  for (int g4 = 0; g4 < 4; ++g4) {
    uint2 o;
    o.x = pack2(st.o0[4 * g4] * inv, st.o0[4 * g4 + 1] * inv); o.y = pack2(st.o0[4 * g4 + 2] * inv, st.o0[4 * g4 + 3] * inv);
    *(uint2*)(yc + 8 * g4 + 4 * h) = o;
    o.x = pack2(st.o1[4 * g4] * inv, st.o1[4 * g4 + 1] * inv); o.y = pack2(st.o1[4 * g4 + 2] * inv, st.o1[4 * g4 + 3] * inv);
    *(uint2*)(yc + 32 + 8 * g4 + 4 * h) = o;
  }
}

DI void dil_item(const Params& p, int b, int hh, int res, int qblk, char* smem, int tid) {
  char* ws = p.ws;
  const int lane = tid & 63, wave = tid >> 6, r = lane & 31, h = lane >> 5;
  const int g = hh >> 1, dl = 2 * g, L = S >> dl;
  const int tq = qblk * 256 + wave * 32 + r;
  const size_t prow = (size_t)b * S + (size_t)res * L + tq;
  bf16x8 qf[4];
  load_q(qf, (const u16*)(ws + A_DQ) + prow * 384 + hh * 64, lane);
  AttnSt st;
  attn_init(st);
  const int lo = qblk * 256 - 128;
  attn_loop<1, false>(st, qf, (const u16*)(ws + A_DK) + ((size_t)b * S + (size_t)res * L) * 384 + hh * 64, 384,
                      (const u16*)(ws + A_DVT) + (size_t)(b * 6 + hh) * 64 * S + (size_t)res * L, S, nullptr, (lo > 0 ? lo : 0) >> 6,
                      4 * qblk + 4, tq, 129, 0ull, 0.f, smem, tid);
  const float lt = st.l + __shfl_xor(st.l, 32);
  const float inv = lt > 0.f ? 1.f / lt : 0.f;
  const int tnat = (tq << dl) + res;
  const size_t nrow = (size_t)b * S + tnat;
  float* dp = (float*)(ws + A_DILP) + ((size_t)g * T + nrow) * 128 + (hh & 1) * 64;
#pragma unroll
  for (int g4 = 0; g4 < 4; ++g4) {
    *(float4*)(dp + 8 * g4 + 4 * h) = make_float4(st.o0[4 * g4] * inv, st.o0[4 * g4 + 1] * inv, st.o0[4 * g4 + 2] * inv, st.o0[4 * g4 + 3] * inv);
    *(float4*)(dp + 32 + 8 * g4 + 4 * h) = make_float4(st.o1[4 * g4] * inv, st.o1[4 * g4 + 1] * inv, st.o1[4 * g4 + 2] * inv, st.o1[4 * g4 + 3] * inv);
  }
  if (h == 0) ((float*)(ws + A_DILL))[((size_t)g * T + nrow) * 2 + (hh & 1)] = st.m + __builtin_amdgcn_logf(lt);
}

DI void cmpmlp_item(const Params& p, int l, int item, char* smem, int tid) {
  const int lane = tid & 63, wave = tid >> 6, wm = wave >> 2, wn = wave & 3, h_ = lane >> 5, c_ = lane & 31;
  char* ws = p.ws;
  const int b = item >> 1, j = item & 1;
  const u16* A = (const u16*)(ws + (j ? A_VCMP : A_KCMP)) + (size_t)b * S * 64;
  const u16* W = (const u16*)(ws + OFF_WC1) + (size_t)(l * 2 + j) * 128 * 2048;
  const float* peb = (const float*)(ws + OFF_PEB) + (l * 2 + j) * 128;
  f32x16 acc[4][1];
  zero_acc<4, 1>(acc);
  gemm_first<4, 1>(A, 1024, W, 2048, smem, tid);
  gemm_k<4, 1>(acc, A, 1024, W, 2048, 32, smem, tid, false, A, 1024, W, 2048);
  u16* hc = (u16*)(ws + A_HIDC) + (size_t)(b * 2 + j) * 256 * 128;
  {
    const int h = launder_i(h_), c = launder_i(c_);
    const int col = wn * 32 + c;
    const float pb = peb[col];
#pragma unroll
    for (int mi = 0; mi < 4; ++mi)
#pragma unroll
      for (int i = 0; i < 16; ++i) {
        const int row = wm * 128 + mi * 32 + crow(i, h);
        hc[(size_t)row * 128 + col] = f2bf(siluf_(acc[mi][0][i] + pb));
      }
  }
  asm volatile("s_waitcnt vmcnt(0)" ::: "memory");
  __syncthreads();
  const u16* W2 = (const u16*)(ws + OFF_WC2) + (size_t)(l * 2 + j) * 128 * 128;
  zero_acc<4, 1>(acc);
  gemm_first<4, 1>(hc, 128, W2, 128, smem, tid);
  gemm_k<4, 1>(acc, hc, 128, W2, 128, 2, smem, tid, false, hc, 128, W2, 128);
  const int h = launder_i(h_), c = launder_i(c_);
  if (wn < 2) {
    const int d = wn * 32 + c;
#pragma unroll
    for (int mi = 0; mi < 4; ++mi)
#pragma unroll
      for (int i = 0; i < 16; ++i) {
        const int row = wm * 128 + mi * 32 + crow(i, h);
        const float v = row < 255 ? acc[mi][0][i] : 0.f;
        if (j == 0) ((u16*)(ws + A_KC))[((size_t)b * 256 + row) * 64 + d] = f2bf(v);
        else ((u16*)(ws + A_VCT))[((size_t)b * 64 + d) * 256 + row] = f2bf(v);
      }
  }
}
DI void cumsum_item(const Params& p, int item, int tid) {
  const int lane = tid & 63, wave = tid >> 6;
  char* ws = p.ws;
  const int wi = item * 8 + wave;
  const int b = wi / 6, hd = wi % 6;
  const float* fl = (const float*)(ws + A_FLOG) + (size_t)b * S * 6 + hd;
  float* cum = (float*)(ws + A_CUM) + (size_t)(b * 6 + hd) * S;
  float ssum = 0.f;
  for (int k = 0; k < 64; ++k) ssum += fl[(size_t)(lane * 64 + k) * 6];
  float incl = ssum;
  for (int o = 1; o < 64; o <<= 1) { const float v = __shfl_up(incl, o); if (lane >= o) incl += v; }
  float run = incl - ssum;
  for (int k = 0; k < 64; ++k) { run += fl[(size_t)(lane * 64 + k) * 6]; cum[lane * 64 + k] = run; }
}
DI void q_publish(unsigned* cnt, int tid) {
  asm volatile("s_waitcnt vmcnt(0)" ::: "memory");
  __syncthreads();
  if (tid == 0) {
    __builtin_amdgcn_fence(__ATOMIC_RELEASE, "agent");
    asm volatile("s_waitcnt vmcnt(0)" ::: "memory");
    __hip_atomic_fetch_add(cnt, 1u, __ATOMIC_RELAXED, __HIP_MEMORY_SCOPE_AGENT);
  }
}
DI void q_wait(unsigned* cnt, unsigned n, int tid) {
  if (tid == 0) {
    while (__hip_atomic_load(cnt, __ATOMIC_RELAXED, __HIP_MEMORY_SCOPE_AGENT) < n) __builtin_amdgcn_s_sleep(4);
    __builtin_amdgcn_fence(__ATOMIC_ACQUIRE, "agent");
    asm volatile("s_waitcnt vmcnt(0)" ::: "memory");
  }
  __syncthreads();
}
constexpr int Q_CMP = 16, Q_CUM = 6, Q_DIL = 768, Q_PRE = Q_CMP + Q_CUM + Q_DIL;
constexpr int ATT_MAIN = 16 * 80;
constexpr int ATT_TOTAL = Q_PRE + ATT_MAIN;
DI void attn_phase(const Params& p, int l, char* smem, int tid0) {
  unsigned* ctr = (unsigned*)(p.ws + OFF_CTR) + l;
  unsigned* cmp_done = (unsigned*)(p.ws + OFF_CTR) + 8 + l;
  unsigned* cum_done = (unsigned*)(p.ws + OFF_CTR) + 12 + l;
  int* ip = (int*)(smem + SM_ITEM);
  bool got_cmp = false, got_cum = false;
  for (;;) {
    const int tid = launder_i(tid0);
    __syncthreads();
    if (tid == 0) *ip = (int)atomicAdd(ctr, 1u);
    __syncthreads();
    const int idx = *ip;
    if (idx >= ATT_TOTAL) break;
    if (idx < Q_CMP) {
      cmpmlp_item(p, l, idx, smem, tid);
      q_publish(cmp_done, tid);
    } else if (idx < Q_CMP + Q_CUM) {
      cumsum_item(p, idx - Q_CMP, tid);
      q_publish(cum_done, tid);
    } else if (idx < Q_PRE) {
      const int e = idx - Q_CMP - Q_CUM;
      const int bh = e >> 4, sub = e & 15;
      const int b = bh / 6, hh = bh % 6, g = hh >> 1;
      const int nblk = 16 >> (2 * g);
      dil_item(p, b, hh, sub / nblk, sub % nblk, smem, tid);
    } else {
      const int m = idx - Q_PRE;
      const int k = 15 - m / 80, rr = m % 80;
      if (rr < 48) {
        if (!got_cum) { q_wait(cum_done, Q_CUM, tid); got_cum = true; }
        fox_item(p, rr / 6, rr % 6, k, smem, tid);
      } else {
        if (!got_cmp) { q_wait(cmp_done, Q_CMP, tid); got_cmp = true; }
        const int e = rr - 48;
        nsa_item(p, e & 7, 4 * k + 3 - (e >> 3), smem, tid);
      }
    }
  }
}

DI void dilcomb_phase(const Params& p, int tid) {
  char* ws = p.ws;
  const float* dp = (const float*)(ws + A_DILP);
  const float* dlse = (const float*)(ws + A_DILL);
  u16* yb = (u16*)(ws + A_YB);
  for (size_t idx = (size_t)blockIdx.x * 512 + tid; idx < (size_t)T * 32; idx += (size_t)gridDim.x * 512) {
    const size_t row = idx >> 5;
    const int c4 = (int)(idx & 31), hs = c4 >> 4;
    const float l0 = dlse[((size_t)0 * T + row) * 2 + hs], l1 = dlse[((size_t)1 * T + row) * 2 + hs], l2 = dlse[((size_t)2 * T + row) * 2 + hs];
    const float mx = fmaxf(l0, fmaxf(l1, l2));
    float w0 = __builtin_amdgcn_exp2f(l0 - mx), w1 = __builtin_amdgcn_exp2f(l1 - mx), w2 = __builtin_amdgcn_exp2f(l2 - mx);
    const float inv = 1.f / (w0 + w1 + w2);
    w0 *= inv; w1 *= inv; w2 *= inv;
    const float4 a = *(const float4*)(dp + ((size_t)0 * T + row) * 128 + c4 * 4);
    const float4 bq = *(const float4*)(dp + ((size_t)1 * T + row) * 128 + c4 * 4);
    const float4 cq = *(const float4*)(dp + ((size_t)2 * T + row) * 128 + c4 * 4);
    uint2 o;
    o.x = pack2(w0 * a.x + w1 * bq.x + w2 * cq.x, w0 * a.y + w1 * bq.y + w2 * cq.y);
    o.y = pack2(w0 * a.z + w1 * bq.z + w2 * cq.z, w0 * a.w + w1 * bq.w + w2 * cq.w);
    *(uint2*)(yb + row * 128 + c4 * 4) = o;
  }
}

DI void merge_phase(const Params& p, int l, char* smem, int tid) {
  char* ws = p.ws;
  const u16* N = (const u16*)(ws + OFF_NBUF);
  const u16* WG = (const u16*)(ws + OFF_WMIX + (size_t)l * SZ_WMIX) + (size_t)3072 * 1024;
  u16* mg = (u16*)(ws + A_MERGED);
  int mt, nt, mt2 = 0, nt2 = 0;
  bool have = tile_coords(0, 8, 4, 128 * 8, mt, nt);
  if (have) gemm_first<4, 1>(N + (size_t)mt * 256 * 1024, 1024, WG + (size_t)nt * 128 * 1024, 1024, smem, tid);
  for (int it = 0; have; ++it, mt = mt2, nt = nt2) {
    const bool have2 = tile_coords(it + 1, 8, 4, 128 * 8, mt2, nt2);
    if (!have2) { mt2 = mt; nt2 = nt; }
    have = have2;
    f32x4 macc[8][2];
    zero_acc16<2>(macc);
#pragma unroll 1
    for (int br = 0; br < 3; ++br) {
      const u16* Y = br == 0 ? (const u16*)(ws + A_YA) : br == 1 ? (const u16*)(ws + A_YB) : (const u16*)(ws + A_YC);
      const int KB = br == 0 ? 256 : br == 1 ? 128 : 384;
      const u16* WB = br == 0 ? (const u16*)(ws + OFF_WBRA) + (size_t)l * 1024 * 256
                    : br == 1 ? (const u16*)(ws + OFF_WBRB) + (size_t)l * 1024 * 128
                              : (const u16*)(ws + OFF_WBRC) + (size_t)l * 1024 * 384;
      const u16* Ay = Y + (size_t)mt * 256 * KB;
      const u16* By = WB + (size_t)nt * 128 * KB;
      f32x4 acc[8][2];
      zero_acc16<2>(acc);
      gemm_k16<2>(acc, N + (size_t)mt * 256 * 1024, 1024, WG + ((size_t)br * 1024 + nt * 128) * 1024, 1024, 16, smem, tid, true, Ay, KB, By, KB);
      unsigned sg[8][2][2];
#pragma unroll
      for (int a = 0; a < 8; ++a)
#pragma unroll
        for (int bb = 0; bb < 2; ++bb) {
          sg[a][bb][0] = pack2(sigmoidf_(acc[a][bb].x), sigmoidf_(acc[a][bb].y));
          sg[a][bb][1] = pack2(sigmoidf_(acc[a][bb].z), sigmoidf_(acc[a][bb].w));
        }
      zero_acc16<2>(acc);
      const bool last = (br == 2);
      const int mtn = last ? mt2 : mt, ntn = last ? nt2 : nt, brn = last ? 0 : br + 1;
      gemm_k16<2>(acc, Ay, KB, By, KB, KB / 64, smem, tid, last ? have2 : true, N + (size_t)mtn * 256 * 1024, 1024,
                  WG + ((size_t)brn * 1024 + ntn * 128) * 1024, 1024);
#pragma unroll
      for (int a = 0; a < 8; ++a)
#pragma unroll
        for (int bb = 0; bb < 2; ++bb) {
          macc[a][bb].x += __uint_as_float(sg[a][bb][0] << 16) * acc[a][bb].x;
          macc[a][bb].y += __uint_as_float(sg[a][bb][0] & 0xffff0000u) * acc[a][bb].y;
          macc[a][bb].z += __uint_as_float(sg[a][bb][1] << 16) * acc[a][bb].z;
          macc[a][bb].w += __uint_as_float(sg[a][bb][1] & 0xffff0000u) * acc[a][bb].w;
        }
    }
    const int lane = tid & 63, wave = tid >> 6, wm = wave >> 2, wn = wave & 3, q = lane >> 4, c = lane & 15;
    const unsigned ebase = (unsigned)(mt * 256 + wm * 128 + 4 * q) * 1024u + (unsigned)(nt * 128 + wn * 32 + c);
#pragma unroll
    for (int mb = 0; mb < 8; ++mb)
#pragma unroll
      for (int nb = 0; nb < 2; ++nb) {
        mg[ebase + (unsigned)(mb * 16 + 0) * 1024u + (unsigned)(nb * 16)] = f2bf(macc[mb][nb].x);
        mg[ebase + (unsigned)(mb * 16 + 1) * 1024u + (unsigned)(nb * 16)] = f2bf(macc[mb][nb].y);
        mg[ebase + (unsigned)(mb * 16 + 2) * 1024u + (unsigned)(nb * 16)] = f2bf(macc[mb][nb].z);
        mg[ebase + (unsigned)(mb * 16 + 3) * 1024u + (unsigned)(nb * 16)] = f2bf(macc[mb][nb].w);
      }
  }
}

DI void final_norm_phase(const Params& p, int tid) {
  const int lane = tid & 63, wave = tid >> 6;
  for (int r = blockIdx.x * 8 + wave; r < T; r += gridDim.x * 8) {
    f32x4* src = (f32x4*)(p.out + (size_t)r * 1024);
    f32x4 v[4];
    float ss = 0.f;
#pragma unroll
    for (int j = 0; j < 4; ++j) {
      v[j] = src[lane + 64 * j];
      ss += v[j].x * v[j].x + v[j].y * v[j].y + v[j].z * v[j].z + v[j].w * v[j].w;
    }
    for (int o = 32; o; o >>= 1) ss += __shfl_xor(ss, o);
    const float rs = rsqrtf(ss * (1.f / 1024.f) + 1e-6f);
#pragma unroll
    for (int j = 0; j < 4; ++j) {
      const float4 gg = ((const float4*)p.final_g)[lane + 64 * j];
      f32x4 o4;
      o4.x = v[j].x * rs * gg.x; o4.y = v[j].y * rs * gg.y; o4.z = v[j].z * rs * gg.z; o4.w = v[j].w * rs * gg.w;
      src[lane + 64 * j] = o4;
    }
  }
}

DI int my_tid(int wave_s) { return wave_s * 64 + (int)__builtin_amdgcn_mbcnt_hi(~0u, __builtin_amdgcn_mbcnt_lo(~0u, 0u)); }
#define XB_TMO      128
#define XB_XCNT(j)  (256  + 64 * (j))
#define XB_XSUB(j)  (1280 + 64 * (j))
#define XB_XGEN(j)  (2304 + 64 * (j))
#define XB_TOP      3328
#define XB_TOPGEN   3392
#define XB_SPIN_CAP (1u << 20)
#define LAS __attribute__((address_space(3)))
DI unsigned xb_ld(unsigned* p) { return __hip_atomic_load(p, __ATOMIC_RELAXED, __HIP_MEMORY_SCOPE_AGENT); }
DI unsigned xb_add(unsigned* p, unsigned v) { return __hip_atomic_fetch_add(p, v, __ATOMIC_RELAXED, __HIP_MEMORY_SCOPE_AGENT); }
DI unsigned xb_xcc_id() { return (unsigned)__builtin_amdgcn_s_getreg((3 << 11) | 20) & 0xFu; }
#define XB_SPIN(cond, bar) do { unsigned _sp = 0; while (cond) { __builtin_amdgcn_s_sleep(1); \
    if ((++_sp & 255u) == 0u) { if (xb_ld(&(bar)[XB_TMO])) break; if (_sp > XB_SPIN_CAP) { atomicAdd(&(bar)[XB_TMO], 1u); break; } } } } while (0)
struct XcdBarrier { unsigned* bar; unsigned x; volatile LAS unsigned* st; };
DI XcdBarrier xcd_barrier_post(unsigned* bar, volatile LAS unsigned* st) {
  XcdBarrier b; b.bar = bar; b.x = xb_xcc_id(); b.st = st;
  if (threadIdx.x == 0) (void)xb_add(&bar[XB_XCNT(b.x)], 1u);
  return b;
}
DI void xcd_barrier_complete(unsigned* bar, unsigned x, unsigned& nloc, unsigned& nx) {
  const unsigned G = gridDim.x * gridDim.y * gridDim.z;
  unsigned sum, cnt, mine, sp = 0u;
  for (;;) {
    sum = 0u; cnt = 0u; mine = 0u;
#pragma unroll
    for (unsigned j = 0; j < 16; ++j) { const unsigned c = xb_ld(&bar[XB_XCNT(j)]); sum += c; cnt += (c > 0u) ? 1u : 0u; mine = (j == x) ? c : mine; }
    if (sum == G) break;
    __builtin_amdgcn_s_sleep(1);
    if ((++sp & 255u) == 0u) { if (xb_ld(&bar[XB_TMO])) break; if (sp > XB_SPIN_CAP) { atomicAdd(&bar[XB_TMO], 1u); break; } }
  }
  nloc = mine > 0u ? mine : 1u; nx = cnt > 0u ? cnt : 1u;
}
DI void xcd_barrier(const XcdBarrier& b) {
  asm volatile("s_waitcnt vmcnt(0)" ::: "memory");
  __syncthreads();
  if (threadIdx.x == 0) {
    unsigned* bar = b.bar;
    __builtin_amdgcn_s_waitcnt(0);
    unsigned nloc = b.st[0], nx = b.st[1];
    if (nloc == 0u) { xcd_barrier_complete(bar, b.x, nloc, nx); b.st[0] = nloc; b.st[1] = nx; }
    const unsigned old = xb_add(&bar[XB_XSUB(b.x)], 1u);
    const unsigned gen = old / nloc;
    if (old + 1u == (gen + 1u) * nloc) {
      __builtin_amdgcn_fence(__ATOMIC_RELEASE, "agent");
      asm volatile("s_waitcnt vmcnt(0)" ::: "memory");
      const unsigned og = xb_add(&bar[XB_TOP], 1u);
      const unsigned tg = og / nx;
      if (og + 1u == (tg + 1u) * nx) xb_add(&bar[XB_TOPGEN], 1u);
      else XB_SPIN(xb_ld(&bar[XB_TOPGEN]) == tg, bar);
      __builtin_amdgcn_fence(__ATOMIC_ACQUIRE, "agent");
      xb_add(&bar[XB_XGEN(b.x)], 1u);
      asm volatile("s_waitcnt vmcnt(0)" ::: "memory");
    } else {
      XB_SPIN(xb_ld(&bar[XB_XGEN(b.x)]) == gen, bar);
      __builtin_amdgcn_fence(__ATOMIC_ACQUIRE, "agent");
      asm volatile("s_waitcnt vmcnt(0)" ::: "memory");
    }
  }
  __syncthreads();
}
DI char* launder_p(char* v) { asm volatile("" : "+s"(v)); return v; }
#define PH(...) { const int tid = launder_i((int)threadIdx.x); Params q = p; q.ws = launder_p(p.ws); q.out = (float*)launder_p((char*)p.out); char* ws = q.ws; (void)ws; (void)tid; __VA_ARGS__; }

template <int l>
DI void layer_body(const Params& p, const XcdBarrier& xb, char* smem) {
    PH(norm_phase(q, (l == 0) ? q.x : q.out, l, 0, tid));
    xcd_barrier(xb);
    PH(ffn1_phase(q, l, 0, smem, tid));
    xcd_barrier(xb);
    PH(resid_gemm_phase(q, (const u16*)(ws + A_HID), DFF, (const u16*)(ws + OFF_WFFN_OUT + (size_t)(l * 2 + 0) * SZ_WFFN_OUT),
                        (l == 0) ? q.x : q.out, q.out, l, 2, 0.5f, smem, tid));
    xcd_barrier(xb);
    PH(norm_phase(q, q.out, l, 1, tid));
    xcd_barrier(xb);
    PH(inproj_phase(q, l, smem, tid));
    xcd_barrier(xb);
    PH(attn_phase(q, l, smem, tid));
    xcd_barrier(xb);
    PH(dilcomb_phase(q, tid));
    xcd_barrier(xb);
    PH(merge_phase(q, l, smem, tid));
    xcd_barrier(xb);
    PH(resid_gemm_phase(q, (const u16*)(ws + A_MERGED), 1024, (const u16*)(ws + OFF_WOUT) + (size_t)l * 1024 * 1024, q.out, q.out, l, 5,
                        1.0f, smem, tid));
    xcd_barrier(xb);
    PH(norm_phase(q, q.out, l, 2, tid));
    xcd_barrier(xb);
    PH(ffn1_phase(q, l, 1, smem, tid));
    xcd_barrier(xb);
    PH(resid_gemm_phase(q, (const u16*)(ws + A_HID), DFF, (const u16*)(ws + OFF_WFFN_OUT + (size_t)(l * 2 + 1) * SZ_WFFN_OUT), q.out, q.out,
                        l, 8, 0.5f, smem, tid));
    xcd_barrier(xb);
}

constexpr int DYN_LDS = 133376 + 16;
__global__ void __launch_bounds__(512, 2) mega(Params p) {
  cg::grid_group grid = cg::this_grid();
  extern __shared__ __attribute__((aligned(16))) char smem[];
  const int wave_s = __builtin_amdgcn_readfirstlane((int)(threadIdx.x >> 6));
  PH(for (int idx = blockIdx.x; idx < P0_TOTAL; idx += gridDim.x) phase0_item(q, idx, smem, tid));
  grid.sync();
  PH({
    const float* part = (const float*)(ws + OFF_MODPART);
    float* mod = (float*)(ws + OFF_MOD);
    for (int i = blockIdx.x * 512 + tid; i < 2 * 8 * 9216; i += gridDim.x * 512) {
      const int l = i / (8 * 9216), j = i % 9216;
      float a = q.ada_b[l * 9216 + j];
      for (int kc = 0; kc < 16; ++kc) a += part[(size_t)kc * (2 * 8 * 9216) + i];
      mod[i] = a;
    }
  });
  volatile LAS unsigned* xst = (volatile LAS unsigned*)(smem + 133376);
  if (threadIdx.x == 0) { xst[0] = 0u; xst[1] = 0u; }
  __syncthreads();
  const XcdBarrier xb = xcd_barrier_post((unsigned*)(p.ws + OFF_XBAR), xst);
  xcd_barrier(xb);
  layer_body<0>(p, xb, smem);
  layer_body<1>(p, xb, smem);
  PH(final_norm_phase(q, tid));
}

extern "C" void kernel_launch(void* const* d_in, const int* in_sizes, int n_in, void* d_out, int out_size, void* d_ws,
                              size_t ws_size, hipStream_t stream) {
  static int grid_blocks = 0;
  if (!grid_blocks) {
    int dev = 0, cus = 0, per_cu = 0;
    (void)hipGetDevice(&dev);
    (void)hipDeviceGetAttribute(&cus, hipDeviceAttributeMultiprocessorCount, dev);
    (void)hipFuncSetAttribute((const void*)mega, hipFuncAttributeMaxDynamicSharedMemorySize, DYN_LDS);
    (void)hipOccupancyMaxActiveBlocksPerMultiprocessor(&per_cu, mega, 512, DYN_LDS);
    if (per_cu > 1) per_cu = 1;
    if (per_cu < 1) per_cu = 1;
    grid_blocks = cus * per_cu;
  }
  Params p{};
  p.x = (const float*)d_in[0]; p.c = (const float*)d_in[1]; p.ada_w = (const float*)d_in[2]; p.ada_b = (const float*)d_in[3];
  p.norm_g = (const float*)d_in[4]; p.final_g = (const float*)d_in[5]; p.ffn_w_in = (const float*)d_in[6];
  p.ffn_w_out = (const float*)d_in[7]; p.mix_w_in = (const float*)d_in[8]; p.cmp_pe = (const float*)d_in[9];
  p.cmp_w1 = (const float*)d_in[10]; p.cmp_w2 = (const float*)d_in[11]; p.fox_bias = (const float*)d_in[12];
  p.br_nsa = (const float*)d_in[13]; p.br_dil = (const float*)d_in[14]; p.br_fox = (const float*)d_in[15];
  p.mix_w_out = (const float*)d_in[16];
  p.out = (float*)d_out; p.ws = (char*)d_ws;
  void* args[] = {&p};
  hipError_t e = hipLaunchCooperativeKernel((void*)mega, dim3(grid_blocks), dim3(512), args, DYN_LDS, stream);
  if (e != hipSuccess) fprintf(stderr, "cooperative launch failed: %s (grid %d)\n", hipGetErrorString(e), grid_blocks);
}
```

```cpp
#include <hip/hip_runtime.h>
#include <hip/hip_cooperative_groups.h>
#include <cstdio>
namespace cg = cooperative_groups;

typedef unsigned short u16;
typedef unsigned long long u64;
typedef __attribute__((ext_vector_type(8))) short bf16x8;
typedef __attribute__((ext_vector_type(4))) short bf16x4;
typedef __attribute__((ext_vector_type(16))) float f32x16;
typedef __attribute__((ext_vector_type(2))) __bf16 bf2_t;
typedef __attribute__((ext_vector_type(2))) float f2_t;
typedef __attribute__((ext_vector_type(4))) unsigned u32x4;
typedef __attribute__((ext_vector_type(2))) unsigned u32x2;
typedef __attribute__((ext_vector_type(4))) float f32x4;
#define DI __device__ __forceinline__

constexpr int S = 4096, NB = 8, T = NB * S, DM = 1024, DFF = 2816;
constexpr float LOG2E = 1.4426950408889634f;
constexpr float SC2 = 0.125f * LOG2E;

constexpr size_t SZ_WFFN_IN = (size_t)5632 * 1024 * 2;
constexpr size_t SZ_WFFN_OUT = (size_t)1024 * 2816 * 2;
constexpr size_t SZ_WMIX = (size_t)6144 * 1024 * 2;
constexpr size_t OFF_WFFN_IN = 0;
constexpr size_t OFF_WFFN_OUT = OFF_WFFN_IN + 4 * SZ_WFFN_IN;
constexpr size_t OFF_WMIX = OFF_WFFN_OUT + 4 * SZ_WFFN_OUT;
constexpr size_t OFF_WBRA = OFF_WMIX + 2 * SZ_WMIX;
constexpr size_t OFF_WBRB = OFF_WBRA + 2 * 1024 * 256 * 2;
constexpr size_t OFF_WBRC = OFF_WBRB + 2 * 1024 * 128 * 2;
constexpr size_t OFF_WOUT = OFF_WBRC + 2 * 1024 * 384 * 2;
constexpr size_t OFF_WC1 = OFF_WOUT + 2 * 1024 * 1024 * 2;
constexpr size_t OFF_WC2 = OFF_WC1 + 4 * 128 * 2048 * 2;
constexpr size_t OFF_PEB = OFF_WC2 + 4 * 128 * 128 * 2;
constexpr size_t OFF_MOD = OFF_PEB + 4 * 128 * 4;
constexpr size_t SZ_MOD = (size_t)2 * 8 * 9216 * 4;
constexpr size_t OFF_MODPART = OFF_MOD + SZ_MOD;
constexpr size_t OFF_ROPE = OFF_MODPART + 16 * SZ_MOD;
constexpr size_t OFF_CTR = OFF_ROPE + (size_t)S * 16 * 4;
constexpr size_t OFF_XBAR = OFF_CTR + 256;
constexpr size_t OFF_NBUF = OFF_XBAR + 16384;
constexpr size_t OFF_ARENA = OFF_NBUF + (size_t)T * 1024 * 2;
constexpr size_t A_QNSA = OFF_ARENA;
constexpr size_t A_KCMP = A_QNSA + (size_t)T * 256 * 2;
constexpr size_t A_VCMP = A_KCMP + (size_t)T * 64 * 2 + 4096;
constexpr size_t A_KSEL = A_VCMP + (size_t)T * 64 * 2 + 4096;
constexpr size_t A_VSELT = A_KSEL + (size_t)T * 64 * 2;
constexpr size_t A_KWIN = A_VSELT + (size_t)T * 64 * 2;
constexpr size_t A_VWINT = A_KWIN + (size_t)T * 64 * 2;
constexpr size_t A_DQ = A_VWINT + (size_t)T * 64 * 2;
constexpr size_t A_DK = A_DQ + (size_t)T * 384 * 2;
constexpr size_t A_DVT = A_DK + (size_t)T * 384 * 2;
constexpr size_t A_FQ = A_DVT + (size_t)T * 384 * 2;
constexpr size_t A_FK = A_FQ + (size_t)T * 384 * 2;
constexpr size_t A_FVT = A_FK + (size_t)T * 384 * 2;
constexpr size_t A_GNSA = A_FVT + (size_t)T * 384 * 2;
constexpr size_t A_FLOG = A_GNSA + (size_t)T * 12 * 4;
constexpr size_t A_CUM = A_FLOG + (size_t)T * 6 * 4;
constexpr size_t A_KC = A_CUM + (size_t)T * 6 * 4;
constexpr size_t A_VCT = A_KC + (size_t)NB * 256 * 64 * 2;
constexpr size_t A_HIDC = A_VCT + (size_t)NB * 256 * 64 * 2;
constexpr size_t A_YA = A_HIDC + (size_t)NB * 2 * 256 * 128 * 2;
constexpr size_t A_YB = A_YA + (size_t)T * 256 * 2;
constexpr size_t A_YC = A_YB + (size_t)T * 128 * 2;
constexpr size_t A_DILP = A_YC + (size_t)T * 384 * 2;
constexpr size_t A_DILL = A_DILP + (size_t)3 * T * 128 * 4;
constexpr size_t A_END = A_DILL + (size_t)3 * T * 2 * 4;
constexpr size_t A_HID = OFF_ARENA;
constexpr size_t A_MERGED = OFF_ARENA;
static_assert(A_END <= (size_t)512 * 1024 * 1024, "workspace overflow");
static_assert(A_MERGED + (size_t)T * 1024 * 2 <= A_GNSA, "merged aliases live data");

struct Params {
  const float *x, *c, *ada_w, *ada_b, *norm_g, *final_g, *ffn_w_in, *ffn_w_out, *mix_w_in, *cmp_pe, *cmp_w1,
      *cmp_w2, *fox_bias, *br_nsa, *br_dil, *br_fox, *mix_w_out;
  float* out;
  char* ws;
};

DI unsigned pack2(float lo, float hi) {
  f2_t v = {lo, hi};
  bf2_t r = __builtin_convertvector(v, bf2_t);
  return __builtin_bit_cast(unsigned, r);
}
DI u16 f2bf(float f) { return (u16)(pack2(f, 0.f) & 0xffffu); }
DI float sigmoidf_(float x) { return __builtin_amdgcn_rcpf(1.f + __expf(-x)); }
DI float siluf_(float x) { return x * sigmoidf_(x); }
DI int launder_i(int v) { asm volatile("" : "+v"(v)); return v; }
DI int crow(int i, int h) { return (i & 3) + 8 * (i >> 2) + 4 * h; }
DI f32x16 mfma32(bf16x8 a, bf16x8 b, f32x16 c) { return __builtin_amdgcn_mfma_f32_32x32x16_bf16(a, b, c, 0, 0, 0); }
DI f32x16 zero16() { f32x16 z; for (int i = 0; i < 16; ++i) z[i] = 0.f; return z; }

template <int MI, int NI>
DI void g_issue(const u16* A, long lda, const u16* B, long ldb, int k0, char* sA, char* sB, int tid) {
  const unsigned r0 = tid >> 3;
  const unsigned ch = (((tid & 7) ^ ((r0 >> 1) & 7)) * 8) + k0;
  const unsigned la = (unsigned)lda, lb = (unsigned)ldb;
  const int wave = tid >> 6;
#pragma unroll
  for (int i = 0; i < MI; ++i)
    __builtin_amdgcn_global_load_lds((const unsigned*)(A + ((r0 + 64 * i) * la + ch)), (unsigned*)(sA + wave * 1024 + i * 8192), 16, 0, 0);
#pragma unroll
  for (int i = 0; i < 2 * NI; ++i)
    __builtin_amdgcn_global_load_lds((const unsigned*)(B + ((r0 + 64 * i) * lb + ch)), (unsigned*)(sB + wave * 1024 + i * 8192), 16, 0, 0);
}
template <int MI, int NI>
DI void g_frag(bf16x8 (&a)[MI], bf16x8 (&b)[NI], int j, const char* sA, const char* sB, int arow, int brow, int co) {
  if (j < NI) b[j] = *(const bf16x8*)(sB + (brow + j * 32) * 128 + co);
  else a[j - NI] = *(const bf16x8*)(sA + (arow + (j - NI) * 32) * 128 + co);
}
template <int MI, int NI, bool SW = false>
DI void g_step(f32x16 (&acc)[MI][NI], const char* sA, const char* sB, int arow, int brow, int co) {
  bf16x8 a1[MI], b1[NI];
#pragma unroll
  for (int j = 0; j < MI + NI; ++j) g_frag<MI, NI>(a1, b1, j, sA, sB, arow, brow, co);
#pragma unroll
  for (int mi = 0; mi < MI; ++mi)
#pragma unroll
    for (int ni = 0; ni < NI; ++ni) acc[mi][ni] = SW ? mfma32(b1[ni], a1[mi], acc[mi][ni]) : mfma32(a1[mi], b1[ni], acc[mi][ni]);
}
template <int MI, int NI, bool DB>
DI void g_compute(f32x16 (&acc)[MI][NI], const char* sA, const char* sB, int wm, int wn, int lane) {
  const int r = lane & 31, h = lane >> 5;
  const int swz = (r >> 1) & 7;
  const int arow = wm * 32 * MI + r, brow = wn * 32 * NI + r;
  if (!DB) {
#pragma unroll
    for (int s = 0; s < 4; ++s) {
      bf16x8 a1[MI], b1[NI];
      const int co1 = (((2 * s + h) ^ swz) << 4);
#pragma unroll
      for (int j = 0; j < MI + NI; ++j) g_frag<MI, NI>(a1, b1, j, sA, sB, arow, brow, co1);
#pragma unroll
      for (int mi = 0; mi < MI; ++mi)
#pragma unroll
        for (int ni = 0; ni < NI; ++ni) acc[mi][ni] = mfma32(a1[mi], b1[ni], acc[mi][ni]);
    }
    return;
  }
  bf16x8 a[2][MI], b[2][NI];
#pragma unroll
  for (int j = 0; j < MI + NI; ++j) g_frag<MI, NI>(a[0], b[0], j, sA, sB, arow, brow, ((h ^ swz) << 4));
#pragma unroll
  for (int s = 0; s < 4; ++s) {
    const int cur = s & 1, nx = cur ^ 1;
    const int co = (((2 * (s + 1) + h) ^ swz) << 4);
#pragma unroll
    for (int mi = 0; mi < MI; ++mi)
#pragma unroll
      for (int ni = 0; ni < NI; ++ni) {
        acc[mi][ni] = mfma32(a[cur][mi], b[cur][ni], acc[mi][ni]);
        const int j = mi * NI + ni;
        if (s < 3 && j < MI + NI) g_frag<MI, NI>(a[nx], b[nx], j, sA, sB, arow, brow, co);
      }
    if (s < 3) {
#pragma unroll
      for (int j = MI * NI; j < MI + NI; ++j) g_frag<MI, NI>(a[nx], b[nx], j, sA, sB, arow, brow, co);
    }
    if (s < 3) {
#pragma unroll
      for (int j = 0; j < MI + NI && j < MI * NI; ++j) {
        __builtin_amdgcn_sched_group_barrier(0x008, 1, 0);
        __builtin_amdgcn_sched_group_barrier(0x100, 1, 0);
      }
      if (MI * NI > MI + NI) __builtin_amdgcn_sched_group_barrier(0x008, MI * NI - (MI + NI), 0);
    }
  }
}
template <int MI, int NI>
DI void gemm_first(const u16* A, long lda, const u16* B, long ldb, char* smem, int tid) {
  asm volatile("" : "+s"(A), "+s"(B));
  __syncthreads();
  g_issue<MI, NI>(A, lda, B, ldb, 0, smem, smem + 32768, tid);
  asm volatile("s_waitcnt vmcnt(0)" ::: "memory");
  __syncthreads();
}
template <int MI, int NI, bool DB = true, bool SW = false>
DI void gemm_k(f32x16 (&acc)[MI][NI], const u16* A, long lda, const u16* B, long ldb, int nkt, char* smem, int tid, bool has_next,
               const u16* nA, long nlda, const u16* nB, long nldb) {
  const int lane = tid & 63, wave = tid >> 6, wm = wave >> 2, wn = wave & 3;
  asm volatile("" : "+s"(A), "+s"(B), "+s"(nA), "+s"(nB));
  for (int kt = 0; kt < nkt; ++kt) {
    char* cur = smem + (kt & 1) * 65536;
    char* nxt = smem + ((kt & 1) ^ 1) * 65536;
    if (!DB) {
      if (kt + 1 < nkt) g_issue<MI, NI>(A, lda, B, ldb, (kt + 1) * 64, nxt, nxt + 32768, tid);
      else if (has_next) g_issue<MI, NI>(nA, nlda, nB, nldb, 0, nxt, nxt + 32768, tid);
      g_compute<MI, NI, false>(acc, cur, cur + 32768, wm, wn, lane);
      asm volatile("s_waitcnt vmcnt(0)" ::: "memory");
      __syncthreads();
      continue;
    }
    const bool late = (wave >= 4);
    const int r_ = lane & 31, h_ = lane >> 5, swz_ = (r_ >> 1) & 7;
    const int arow = wm * 32 * MI + r_, brow = wn * 32 * NI + r_;
    const char* cA = cur; const char* cB = cur + 32768;
    if (late) {
      g_step<MI, NI, SW>(acc, cA, cB, arow, brow, ((0 + h_) ^ swz_) << 4);
      g_step<MI, NI, SW>(acc, cA, cB, arow, brow, ((2 + h_) ^ swz_) << 4);
    }
    if (kt + 1 < nkt) g_issue<MI, NI>(A, lda, B, ldb, (kt + 1) * 64, nxt, nxt + 32768, tid);
    else if (has_next) g_issue<MI, NI>(nA, nlda, nB, nldb, 0, nxt, nxt + 32768, tid);
    if (!late) {
      g_step<MI, NI, SW>(acc, cA, cB, arow, brow, ((0 + h_) ^ swz_) << 4);
      g_step<MI, NI, SW>(acc, cA, cB, arow, brow, ((2 + h_) ^ swz_) << 4);
    }
    g_step<MI, NI, SW>(acc, cA, cB, arow, brow, ((4 + h_) ^ swz_) << 4);
    g_step<MI, NI, SW>(acc, cA, cB, arow, brow, ((6 + h_) ^ swz_) << 4);
    asm volatile("s_waitcnt vmcnt(0)" ::: "memory");
    __syncthreads();
  }
}
DI f32x4 mfma16(bf16x8 a, bf16x8 b, f32x4 c) { return __builtin_amdgcn_mfma_f32_16x16x32_bf16(a, b, c, 0, 0, 0); }
template <int NB>
DI void g_step16(f32x4 (&acc)[8][NB], const char* sA, const char* sB, int arow, int brow, int co) {
  bf16x8 b[NB];
#pragma unroll
  for (int nb = 0; nb < NB; ++nb) b[nb] = *(const bf16x8*)(sB + (brow + nb * 16) * 128 + co);
#pragma unroll
  for (int mb = 0; mb < 8; ++mb) {
    const bf16x8 a = *(const bf16x8*)(sA + (arow + mb * 16) * 128 + co);
#pragma unroll
    for (int nb = 0; nb < NB; ++nb) acc[mb][nb] = mfma16(a, b[nb], acc[mb][nb]);
  }
}
template <int NB>
DI void gemm_k16(f32x4 (&acc)[8][NB], const u16* A, long lda, const u16* B, long ldb, int nkt, char* smem, int tid, bool has_next,
                 const u16* nA, long nlda, const u16* nB, long nldb) {
  constexpr int NI = NB / 2;
  const int lane = tid & 63, wave = tid >> 6, wm = wave >> 2, wn = wave & 3;
  asm volatile("" : "+s"(A), "+s"(B), "+s"(nA), "+s"(nB));
  const int r_ = lane & 15, q_ = lane >> 4, swz_ = (r_ >> 1) & 7;
  const int arow = wm * 128 + r_, brow = wn * 16 * NB + r_;
  const bool late = (wave >= 4);
  for (int kt = 0; kt < nkt; ++kt) {
    char* cur = smem + (kt & 1) * 65536;
    char* nxt = smem + ((kt & 1) ^ 1) * 65536;
    const char* cA = cur; const char* cB = cur + 32768;
    if (late) g_step16(acc, cA, cB, arow, brow, ((0 + q_) ^ swz_) << 4);
    if (kt + 1 < nkt) g_issue<4, NI>(A, lda, B, ldb, (kt + 1) * 64, nxt, nxt + 32768, tid);
    else if (has_next) g_issue<4, NI>(nA, nlda, nB, nldb, 0, nxt, nxt + 32768, tid);
    if (!late) g_step16(acc, cA, cB, arow, brow, ((0 + q_) ^ swz_) << 4);
    g_step16(acc, cA, cB, arow, brow, ((4 + q_) ^ swz_) << 4);
    asm volatile("s_waitcnt vmcnt(0)" ::: "memory");
    __syncthreads();
  }
}
template <int NB>
DI void zero_acc16(f32x4 (&acc)[8][NB]) {
#pragma unroll
  for (int a = 0; a < 8; ++a)
#pragma unroll
    for (int b = 0; b < NB; ++b) acc[a][b] = (f32x4){0.f, 0.f, 0.f, 0.f};
}
template <int MI, int NI>
DI void zero_acc(f32x16 (&acc)[MI][NI]) {
#pragma unroll
  for (int a = 0; a < MI; ++a)
#pragma unroll
    for (int b = 0; b < NI; ++b) acc[a][b] = zero16();
}
DI bool tile_coords(int it, int NT, int SN, int total, int& mt, int& nt) {
  const int G = gridDim.x, b = blockIdx.x;
  int L = it * G + ((G & 7) == 0 ? ((b & 7) * (G >> 3) + (b >> 3)) : b);
  if (L >= total) return false;
  const int SM = 32 / SN, nst = NT / SN;
  const int stl = L >> 5, w = L & 31;
  const int stm = stl / nst, stn = stl - stm * nst;
  mt = stm * SM + w / SN;
  nt = stn * SN + (w % SN);
  return true;
}

template <bool VEC, class CM>
DI void conv_tile(const float* src, long ldsrc, int k0, u16* dst, long lddst, int n0, CM cm, float* sm, int tid) {
  const int r = tid >> 2, cc = (tid & 3) * 8;
  float v[8];
  const float* rowp = src + (long)(k0 + r) * ldsrc;
  if (VEC) {
    const int c0 = cm(cc);
    if (c0 >= 0) {
      float4 a = *(const float4*)(rowp + c0), b = *(const float4*)(rowp + c0 + 4);
      v[0] = a.x; v[1] = a.y; v[2] = a.z; v[3] = a.w; v[4] = b.x; v[5] = b.y; v[6] = b.z; v[7] = b.w;
    } else {
      for (int j = 0; j < 8; ++j) v[j] = 0.f;
    }
  } else {
#pragma unroll
    for (int j = 0; j < 8; ++j) { const int c = cm(cc + j); v[j] = c >= 0 ? rowp[c] : 0.f; }
  }
  __syncthreads();
#pragma unroll
  for (int j = 0; j < 8; ++j) sm[r * 33 + cc + j] = v[j];
  __syncthreads();
  const int n = tid >> 3, kc = (tid & 7) * 8;
  uint4 o;
  o.x = pack2(sm[(kc + 0) * 33 + n], sm[(kc + 1) * 33 + n]);
  o.y = pack2(sm[(kc + 2) * 33 + n], sm[(kc + 3) * 33 + n]);
  o.z = pack2(sm[(kc + 4) * 33 + n], sm[(kc + 5) * 33 + n]);
  o.w = pack2(sm[(kc + 6) * 33 + n], sm[(kc + 7) * 33 + n]);
  *(uint4*)(dst + (long)(n0 + n) * lddst + k0 + kc) = o;
}

constexpr int CV_FFN_IN = 4 * 88 * 16;
constexpr int CV_FFN_OUT = 4 * 16 * 44;
constexpr int CV_MIX = 2 * 96 * 16;
constexpr int CV_BRA = 2 * 16 * 4;
constexpr int CV_BRB = 2 * 16 * 2;
constexpr int CV_BRC = 2 * 16 * 6;
constexpr int CV_WOUT = 2 * 16 * 16;
constexpr int CV_C1 = 4 * 2 * 32;
constexpr int CV_C2 = 4 * 2 * 2;
constexpr int CV_TOTAL = CV_FFN_IN + CV_FFN_OUT + CV_MIX + CV_BRA + CV_BRB + CV_BRC + CV_WOUT + CV_C1 + CV_C2;
constexpr int P0_ADA = 144, P0_PEB = 4, P0_ROPE = 8;
constexpr int P0_TOTAL = CV_TOTAL + P0_ADA + P0_PEB + P0_ROPE;

DI void phase0_item(const Params& p, int idx, char* smem, int tid512) {
  const int half = tid512 >> 8, tid = tid512 & 255;
  float* sm = (float*)smem + half * (64 * 33);
  char* ws = p.ws;
  if (idx < P0_ADA) {
    const int lane = tid512 & 63, wave = tid512 >> 6;
    const int wi = idx * 8 + wave;
    const int l = wi / 576, rem = wi % 576, kc = rem / 36, cgp = rem % 36;
    const int col = cgp * 256 + lane * 4;
    f32x4 acc[8];
#pragma unroll
    for (int b = 0; b < 8; ++b) acc[b] = (f32x4){0.f, 0.f, 0.f, 0.f};
    for (int k0 = kc * 64; k0 < kc * 64 + 64; k0 += 8) {
      f32x4 w[8];
#pragma unroll
      for (int u = 0; u < 8; ++u) w[u] = *(const f32x4*)(p.ada_w + ((size_t)l * 1024 + k0 + u) * 9216 + col);
#pragma unroll
      for (int u = 0; u < 8; ++u)
#pragma unroll
        for (int b = 0; b < 8; ++b) {
          const float cb = siluf_(p.c[b * 1024 + k0 + u]);
          acc[b] += cb * w[u];
        }
    }
    float* part = (float*)(ws + OFF_MODPART) + (size_t)kc * (2 * 8 * 9216);
#pragma unroll
    for (int b = 0; b < 8; ++b) *(f32x4*)(part + ((size_t)l * 8 + b) * 9216 + col) = acc[b];
    return;
  }
  idx -= P0_ADA;
  if (idx < P0_PEB) {
    const int m = idx, colc = tid512 & 127, kq = tid512 >> 7;
    const float* pe = p.cmp_pe + (size_t)m * 2048;
    const float* w1 = p.cmp_w1 + (size_t)m * 2048 * 128;
    float a = 0.f;
    for (int k0 = kq * 512; k0 < kq * 512 + 512; k0 += 8) {
      float wv[8], pv8[8];
#pragma unroll
      for (int u = 0; u < 8; ++u) { wv[u] = w1[(size_t)(k0 + u) * 128 + colc]; pv8[u] = pe[k0 + u]; }
#pragma unroll
      for (int u = 0; u < 8; ++u) a += pv8[u] * wv[u];
    }
    float* smf = (float*)smem;
    __syncthreads();
    smf[tid512] = a;
    __syncthreads();
    if (tid512 < 128) ((float*)(ws + OFF_PEB))[m * 128 + tid512] = smf[tid512] + smf[tid512 + 128] + smf[tid512 + 256] + smf[tid512 + 384];
    return;
  }
  idx -= P0_PEB;
  if (idx < P0_ROPE) {
    const int t = idx * 512 + tid512;
    float* rp = (float*)(ws + OFF_ROPE) + (size_t)t * 16;
    for (int f = 0; f < 8; ++f) {
      const float inv = (float)pow(500000.0, -(double)f / 8.0);
      const float ang = (float)t * inv;
      rp[f] = (float)cos((double)ang);
      rp[8 + f] = (float)sin((double)ang);
    }
    if (idx == 0 && tid512 < 64) ((unsigned*)(ws + OFF_CTR))[tid512] = 0u;
    if (idx == 0) for (int i = tid512; i < 4096; i += 512) ((unsigned*)(ws + OFF_XBAR))[i] = 0u;
    return;
  }
  idx -= P0_ROPE;
  if (idx < CV_FFN_IN) {
    const int m = idx / (88 * 16), r = idx % (88 * 16), ng = (r / 16) * 2 + half, kt = r % 16;
    const int n0 = ng * 32;
    const int tile = n0 >> 8, within = n0 & 255, wn = within >> 6, r64 = within & 63, isup = r64 >> 5;
    const int c0 = tile * 128 + wn * 32 + (isup ? 2816 : 0);
    conv_tile<true>(p.ffn_w_in + (size_t)m * 1024 * 5632, 5632, kt * 64, (u16*)(ws + OFF_WFFN_IN + m * SZ_WFFN_IN), 1024, n0,
                    [=](int j) { return c0 + j; }, sm, tid);
    return;
  }
  idx -= CV_FFN_IN;
  if (idx < CV_FFN_OUT) {
    const int m = idx / (16 * 44), r = idx % (16 * 44), ng = (r / 44) * 2 + half, kt = r % 44;
    conv_tile<true>(p.ffn_w_out + (size_t)m * 2816 * 1024, 1024, kt * 64, (u16*)(ws + OFF_WFFN_OUT + m * SZ_WFFN_OUT), 2816,
                    ng * 32, [=](int j) { return ng * 32 + j; }, sm, tid);
    return;
  }
  idx -= CV_FFN_OUT;
  if (idx < CV_MIX) {
    const int l = idx / (96 * 16), r = idx % (96 * 16), ng = (r / 16) * 2 + half, kt = r % 16;
    const int n0 = ng * 32;
    conv_tile<false>(p.mix_w_in + (size_t)l * 1024 * 6034, 6034, kt * 64, (u16*)(ws + OFF_WMIX + l * SZ_WMIX), 1024, n0,
                     [=](int j) {
                       const int n = n0 + j;
                       if (n < 640) return n;
                       if (n < 1792) return 652 + (n - 640);
                       if (n < 2944) return 1804 + (n - 1792);
                       if (n < 3072) { const int g = n - 2944; return g < 12 ? 640 + g : (g < 18 ? 2956 + (g - 12) : -1); }
                       return 2962 + (n - 3072);
                     },
                     sm, tid);
    return;
  }
  idx -= CV_MIX;
  if (idx < CV_BRA) {
    const int l = idx / 64, r = idx % 64, ng = (r / 4) * 2 + half, kt = r % 4;
    conv_tile<true>(p.br_nsa + (size_t)l * 256 * 1024, 1024, kt * 64, (u16*)(ws + OFF_WBRA) + (size_t)l * 1024 * 256, 256, ng * 32,
                    [=](int j) { return ng * 32 + j; }, sm, tid);
    return;
  }
  idx -= CV_BRA;
  if (idx < CV_BRB) {
    const int l = idx / 32, r = idx % 32, ng = (r / 2) * 2 + half, kt = r % 2;
    conv_tile<true>(p.br_dil + (size_t)l * 128 * 1024, 1024, kt * 64, (u16*)(ws + OFF_WBRB) + (size_t)l * 1024 * 128, 128, ng * 32,
                    [=](int j) { return ng * 32 + j; }, sm, tid);
    return;
  }
  idx -= CV_BRB;
  if (idx < CV_BRC) {
    const int l = idx / 96, r = idx % 96, ng = (r / 6) * 2 + half, kt = r % 6;
    conv_tile<true>(p.br_fox + (size_t)l * 384 * 1024, 1024, kt * 64, (u16*)(ws + OFF_WBRC) + (size_t)l * 1024 * 384, 384, ng * 32,
                    [=](int j) { return ng * 32 + j; }, sm, tid);
    return;
  }
  idx -= CV_BRC;
  if (idx < CV_WOUT) {
    const int l = idx / 256, r = idx % 256, ng = (r / 16) * 2 + half, kt = r % 16;
    conv_tile<true>(p.mix_w_out + (size_t)l * 1024 * 1024, 1024, kt * 64, (u16*)(ws + OFF_WOUT) + (size_t)l * 1024 * 1024, 1024,
                    ng * 32, [=](int j) { return ng * 32 + j; }, sm, tid);
    return;
  }
  idx -= CV_WOUT;
  if (idx < CV_C1) {
    const int m = idx / 64, r = idx % 64, ng = (r / 32) * 2 + half, kt = r % 32;
    conv_tile<true>(p.cmp_w1 + (size_t)m * 2048 * 128, 128, kt * 64, (u16*)(ws + OFF_WC1) + (size_t)m * 128 * 2048, 2048, ng * 32,
                    [=](int j) { return ng * 32 + j; }, sm, tid);
    return;
  }
  idx -= CV_C1;
  if (idx < CV_C2) {
    const int m = idx / 4, r = idx % 4, ng = (r / 2) * 2 + half, kt = r % 2;
    conv_tile<true>(p.cmp_w2 + (size_t)m * 128 * 64, 64, kt * 64, (u16*)(ws + OFF_WC2) + (size_t)m * 128 * 128, 128, ng * 32,
                    [=](int j) { return ng < 2 ? ng * 32 + j : -1; }, sm, tid);
    return;
  }
  idx -= CV_C2;
}

DI void norm_phase(const Params& p, const float* hin, int l, int sub, int tid) {
  const int lane = tid & 63, wave = tid >> 6;
  const float* g = p.norm_g + ((size_t)l * 3 + sub) * 1024;
  const float* mod = (const float*)(p.ws + OFF_MOD) + (size_t)l * 8 * 9216;
  u16* nb = (u16*)(p.ws + OFF_NBUF);
  for (int r = blockIdx.x * 8 + wave; r < T; r += gridDim.x * 8) {
    const int b = r >> 12;
    const f32x4* src = (const f32x4*)(hin + (size_t)r * 1024);
    f32x4 v[4];
    float ss = 0.f;
#pragma unroll
    for (int j = 0; j < 4; ++j) {
      v[j] = src[lane + 64 * j];
      ss += v[j].x * v[j].x + v[j].y * v[j].y + v[j].z * v[j].z + v[j].w * v[j].w;
    }
    for (int o = 32; o; o >>= 1) ss += __shfl_xor(ss, o);
    const float rs = rsqrtf(ss * (1.f / 1024.f) + 1e-6f);
    const float4* sh = (const float4*)(mod + (size_t)b * 9216 + (3 * sub) * 1024);
    const float4* sc = (const float4*)(mod + (size_t)b * 9216 + (3 * sub + 1) * 1024);
#pragma unroll
    for (int j = 0; j < 4; ++j) {
      const float4 gg = ((const float4*)g)[lane + 64 * j], s4 = sh[lane + 64 * j], c4 = sc[lane + 64 * j];
      const float a = v[j].x * rs * gg.x * (1.f + c4.x) + s4.x;
      const float bq = v[j].y * rs * gg.y * (1.f + c4.y) + s4.y;
      const float cq = v[j].z * rs * gg.z * (1.f + c4.z) + s4.z;
      const float dq = v[j].w * rs * gg.w * (1.f + c4.w) + s4.w;
      uint2 o; o.x = pack2(a, bq); o.y = pack2(cq, dq);
      *(uint2*)(nb + (size_t)r * 1024 + (lane + 64 * j) * 4) = o;
    }
  }
}

DI bool ffn1_coords(int it, int& mt, int& nt) {
  const int G = gridDim.x, b = blockIdx.x;
  int L = it * G + ((G & 7) == 0 ? ((b & 7) * (G >> 3) + (b >> 3)) : b);
  if (L >= 128 * 22) return false;
  if (L < 2560) {
    const int stl = L >> 5, w = L & 31, stm = stl / 5, stn = stl - stm * 5;
    mt = stm * 8 + (w >> 2); nt = stn * 4 + (w & 3);
  } else {
    const int L2 = L - 2560, stl = L2 >> 5, w = L2 & 31;
    mt = stl * 16 + (w >> 1); nt = 20 + (w & 1);
  }
  return true;
}
DI void ffn1_phase(const Params& p, int l, int f, char* smem, int tid) {
  const u16* A = (const u16*)(p.ws + OFF_NBUF);
  const u16* W = (const u16*)(p.ws + OFF_WFFN_IN + (size_t)(l * 2 + f) * SZ_WFFN_IN);
  u16* hid = (u16*)(p.ws + A_HID);
  const int lane = tid & 63, wave = tid >> 6, wm = wave >> 2, wn = wave & 3, q_ = lane >> 4, c_ = lane & 15;
  int mt, nt, mt2 = 0, nt2 = 0;
  bool have = ffn1_coords(0, mt, nt);
  if (have) gemm_first<4, 2>(A + (size_t)mt * 256 * 1024, 1024, W + (size_t)nt * 256 * 1024, 1024, smem, tid);
  for (int it = 0; have; ++it, mt = mt2, nt = nt2) {
    const bool have2 = ffn1_coords(it + 1, mt2, nt2);
    if (!have2) { mt2 = mt; nt2 = nt; }
    have = have2;
    f32x4 acc[8][4];
    zero_acc16(acc);
    gemm_k16(acc, A + (size_t)mt * 256 * 1024, 1024, W + (size_t)nt * 256 * 1024, 1024, 16, smem, tid, have2,
             A + (size_t)mt2 * 256 * 1024, 1024, W + (size_t)nt2 * 256 * 1024, 1024);
    const int q = launder_i(q_), c = launder_i(c_);
    const unsigned ebase = (unsigned)(mt * 256 + wm * 128 + 4 * q) * (unsigned)DFF + (unsigned)(nt * 128 + wn * 32 + c);
#pragma unroll
    for (int mb = 0; mb < 8; ++mb)
#pragma unroll
      for (int nb = 0; nb < 2; ++nb)
#pragma unroll
        for (int i = 0; i < 4; ++i)
          hid[ebase + (unsigned)(mb * 16 + i) * (unsigned)DFF + (unsigned)(nb * 16)] = f2bf(siluf_(acc[mb][nb][i]) * acc[mb][nb + 2][i]);
  }
}

DI void resid_gemm_phase(const Params& p, const u16* A, int K, const u16* W, const float* hin, float* hout, int l, int gachunk,
                         float scale, char* smem, int tid) {
  const int lane = tid & 63, wave = tid >> 6, wm = wave >> 2, wn = wave & 3, h_ = lane >> 5, c_ = lane & 31;
  const float* mod = (const float*)(p.ws + OFF_MOD) + (size_t)l * 8 * 9216 + gachunk * 1024;
  int mt, nt, mt2 = 0, nt2 = 0;
  bool have = tile_coords(0, 4, 4, 128 * 4, mt, nt);
  if (have) gemm_first<4, 2>(A + (size_t)mt * 256 * K, K, W + (size_t)nt * 256 * K, K, smem, tid);
  for (int it = 0; have; ++it, mt = mt2, nt = nt2) {
    const bool have2 = tile_coords(it + 1, 4, 4, 128 * 4, mt2, nt2);
    if (!have2) { mt2 = mt; nt2 = nt; }
    have = have2;
    f32x16 acc[4][2];
    zero_acc<4, 2>(acc);
    gemm_k<4, 2>(acc, A + (size_t)mt * 256 * K, K, W + (size_t)nt * 256 * K, K, K / 64, smem, tid, have2,
                 A + (size_t)mt2 * 256 * K, K, W + (size_t)nt2 * 256 * K, K);
    const int h = launder_i(h_), c = launder_i(c_);
    const int b = (mt * 256) >> 12;
#pragma unroll
    for (int ni = 0; ni < 2; ++ni) {
      const int col = nt * 256 + wn * 64 + ni * 32 + c;
      const float ga = mod[(size_t)b * 9216 + col] * scale;
      const unsigned ebase = (unsigned)(mt * 256 + wm * 128 + 4 * h) * 1024u + (unsigned)col;
#pragma unroll
      for (int mi = 0; mi < 4; ++mi) {
#pragma unroll
        for (int i = 0; i < 16; ++i) {
          const unsigned eo = ebase + (unsigned)(mi * 32 + (i & 3) + 8 * (i >> 2)) * 1024u;
          hout[eo] = hin[eo] + ga * acc[mi][ni][i];
        }
        __builtin_amdgcn_sched_barrier(0);
      }
    }
  }
}

DI void inproj_phase(const Params& p, int l, char* smem, int tid) {
  const u16* A = (const u16*)(p.ws + OFF_NBUF);
  const u16* W = (const u16*)(p.ws + OFF_WMIX + (size_t)l * SZ_WMIX);
  const float* rope = (const float*)(p.ws + OFF_ROPE);
  char* ws = p.ws;
  const int lane = tid & 63, wave = tid >> 6, wm = wave >> 2, wn = wave & 3, h_ = lane >> 5, c_ = lane & 31;
  int mt, nt, mt2 = 0, nt2 = 0;
  bool have = tile_coords(0, 12, 4, 128 * 12, mt, nt);
  if (have) gemm_first<4, 2>(A + (size_t)mt * 256 * 1024, 1024, W + (size_t)nt * 256 * 1024, 1024, smem, tid);
  for (int it = 0; have; ++it, mt = mt2, nt = nt2) {
    const bool have2 = tile_coords(it + 1, 12, 4, 128 * 12, mt2, nt2);
    if (!have2) { mt2 = mt; nt2 = nt; }
    have = have2;
    f32x16 acc[4][2];
    zero_acc<4, 2>(acc);
    gemm_k<4, 2, true, true>(acc, A + (size_t)mt * 256 * 1024, 1024, W + (size_t)nt * 256 * 1024, 1024, 16, smem, tid, have2,
                             A + (size_t)mt2 * 256 * 1024, 1024, W + (size_t)nt2 * 256 * 1024, 1024);
    const int h = launder_i(h_), c = launder_i(c_);
    const int hidx = nt * 4 + wn;
    const int rowbase = mt * 256 + wm * 128;
    const int b = rowbase >> 12;
    if (hidx == 47) continue;
    if (hidx == 46) {
#pragma unroll
      for (int mi = 0; mi < 4; ++mi) {
        const size_t row = (size_t)rowbase + mi * 32 + c;
#pragma unroll
        for (int i = 0; i < 12; ++i) {
          const int d = (i & 3) + 8 * (i >> 2) + 4 * h;
          const float v = acc[mi][0][i];
          if (d < 12) {
            ((float*)(ws + A_GNSA))[row * 12 + d] = v;
          } else if (d < 18) {
            const float xx = v + p.fox_bias[l * 6 + (d - 12)];
            ((float*)(ws + A_FLOG))[row * 6 + (d - 12)] = fminf(xx, 0.f) - log1pf(__expf(-fabsf(xx)));
          }
        }
        __builtin_amdgcn_sched_barrier(0);
      }
      continue;
    }
    bool do_rope, transposed;
    int pg = 0;
    u16* dst;
    int ld = 64, col0 = 0, nh = 1, hh = 0;
    if (hidx < 4) { dst = (u16*)(ws + A_QNSA); ld = 256; col0 = hidx * 64; do_rope = true; transposed = false; }
    else if (hidx < 10) {
      const int k = hidx - 4;
      dst = (u16*)(ws + (k == 0 ? A_KCMP : k == 1 ? A_VCMP : k == 2 ? A_KSEL : k == 3 ? A_VSELT : k == 4 ? A_KWIN : A_VWINT));
      do_rope = (k & 1) == 0; transposed = (k == 3 || k == 5);
    } else if (hidx < 28) {
      const int k = hidx - 10, which = k / 6; hh = k % 6; pg = hh >> 1; nh = 6;
      if (which == 0) { dst = (u16*)(ws + A_DQ); ld = 384; col0 = hh * 64; do_rope = true; transposed = false; }
      else if (which == 1) { dst = (u16*)(ws + A_DK); ld = 384; col0 = hh * 64; do_rope = true; transposed = false; }
      else { dst = (u16*)(ws + A_DVT); do_rope = false; transposed = true; }
    } else {
      const int k = hidx - 28, which = k / 6; hh = k % 6; nh = 6;
      do_rope = false;
      if (which == 0) { dst = (u16*)(ws + A_FQ); ld = 384; col0 = hh * 64; transposed = false; }
      else if (which == 1) { dst = (u16*)(ws + A_FK); ld = 384; col0 = hh * 64; transposed = false; }
      else { dst = (u16*)(ws + A_FVT); transposed = true; }
    }
    const int dl = pg * 2;
#pragma unroll
    for (int mi = 0; mi < 4; ++mi) {
      __builtin_amdgcn_sched_barrier(0);
      const int t = (rowbase + mi * 32 + c) & (S - 1);
      const int pidx = ((t & ((1 << dl) - 1)) << (12 - dl)) + (t >> dl);
      if (do_rope) {
        const f32x4 cs = *(const f32x4*)(rope + t * 16 + 4 * h), sn = *(const f32x4*)(rope + t * 16 + 8 + 4 * h);
#pragma unroll
        for (int i = 0; i < 4; ++i) {
          const float x1 = acc[mi][0][i], x2 = acc[mi][0][i + 4];
          const float cc = i == 0 ? cs.x : i == 1 ? cs.y : i == 2 ? cs.z : cs.w;
          const float ss = i == 0 ? sn.x : i == 1 ? sn.y : i == 2 ? sn.z : sn.w;
          acc[mi][0][i] = x1 * cc - x2 * ss;
          acc[mi][0][i + 4] = x2 * cc + x1 * ss;
        }
      }
      if (!transposed) {
        const unsigned obase = (unsigned)(b * S + pidx) * (unsigned)ld + (unsigned)(col0 + 4 * h);
#pragma unroll
        for (int ni = 0; ni < 2; ++ni) {
#pragma unroll
          for (int g4 = 0; g4 < 4; ++g4) {
            u32x2 o;
            o.x = pack2(acc[mi][ni][4 * g4 + 0], acc[mi][ni][4 * g4 + 1]);
            o.y = pack2(acc[mi][ni][4 * g4 + 2], acc[mi][ni][4 * g4 + 3]);
            *(u32x2*)(dst + (obase + (unsigned)(ni * 32 + 8 * g4))) = o;
          }
          __builtin_amdgcn_sched_barrier(0);
        }
      } else {
        const unsigned obase = (unsigned)((b * nh + hh) * 64 + 4 * h) * (unsigned)S + (unsigned)pidx;
#pragma unroll
        for (int ni = 0; ni < 2; ++ni) {
#pragma unroll
          for (int i = 0; i < 16; ++i)
            dst[obase + (unsigned)(ni * 32 + (i & 3) + 8 * (i >> 2)) * (unsigned)S] = f2bf(acc[mi][ni][i]);
          __builtin_amdgcn_sched_barrier(0);
        }
      }
    }
  }
}

DI void cmp1_phase(const Params& p, int l, char* smem, int tid) {
  const int lane = tid & 63, wave = tid >> 6, wm = wave >> 2, wn = wave & 3, h_ = lane >> 5, c_ = lane & 31;
  char* ws = p.ws;
  for (int item = blockIdx.x; item < 16 + 6; item += gridDim.x) {
    if (item < 16) {
      const int b = item >> 1, j = item & 1;
      const u16* A = (const u16*)(ws + (j ? A_VCMP : A_KCMP)) + (size_t)b * S * 64;
      const u16* W = (const u16*)(ws + OFF_WC1) + (size_t)(l * 2 + j) * 128 * 2048;
      const float* peb = (const float*)(ws + OFF_PEB) + (l * 2 + j) * 128;
      f32x16 acc[4][1];
      zero_acc<4, 1>(acc);
      gemm_first<4, 1>(A, 1024, W, 2048, smem, tid);
      gemm_k<4, 1>(acc, A, 1024, W, 2048, 32, smem, tid, false, A, 1024, W, 2048);
      const int h = launder_i(h_), c = launder_i(c_);
      u16* hc = (u16*)(ws + A_HIDC) + (size_t)(b * 2 + j) * 256 * 128;
      const int col = wn * 32 + c;
      const float pb = peb[col];
#pragma unroll
      for (int mi = 0; mi < 4; ++mi)
#pragma unroll
        for (int i = 0; i < 16; ++i) {
          const int row = wm * 128 + mi * 32 + crow(i, h);
          hc[(size_t)row * 128 + col] = f2bf(siluf_(acc[mi][0][i] + pb));
        }
    } else {
      const int wi = (item - 16) * 8 + wave;
      const int b = wi / 6, hd = wi % 6;
      const float* fl = (const float*)(ws + A_FLOG) + (size_t)b * S * 6 + hd;
      float* cum = (float*)(ws + A_CUM) + (size_t)(b * 6 + hd) * S;
      float ssum = 0.f;
      for (int k = 0; k < 64; ++k) ssum += fl[(size_t)(lane * 64 + k) * 6];
      float incl = ssum;
      for (int o = 1; o < 64; o <<= 1) { const float v = __shfl_up(incl, o); if (lane >= o) incl += v; }
      float run = incl - ssum;
      for (int k = 0; k < 64; ++k) { run += fl[(size_t)(lane * 64 + k) * 6]; cum[lane * 64 + k] = run; }
    }
  }
}
DI void cmp2_phase(const Params& p, int l, char* smem, int tid) {
  const int lane = tid & 63, wave = tid >> 6, wm = wave >> 2, wn = wave & 3, h_ = lane >> 5, c_ = lane & 31;
  char* ws = p.ws;
  for (int item = blockIdx.x; item < 16; item += gridDim.x) {
    const int b = item >> 1, j = item & 1;
    const u16* A = (const u16*)(ws + A_HIDC) + (size_t)(b * 2 + j) * 256 * 128;
    const u16* W = (const u16*)(ws + OFF_WC2) + (size_t)(l * 2 + j) * 128 * 128;
    f32x16 acc[4][1];
    zero_acc<4, 1>(acc);
    gemm_first<4, 1>(A, 128, W, 128, smem, tid);
    gemm_k<4, 1>(acc, A, 128, W, 128, 2, smem, tid, false, A, 128, W, 128);
    const int h = launder_i(h_), c = launder_i(c_);
    if (wn < 2) {
      const int d = wn * 32 + c;
#pragma unroll
      for (int mi = 0; mi < 4; ++mi)
#pragma unroll
        for (int i = 0; i < 16; ++i) {
          const int row = wm * 128 + mi * 32 + crow(i, h);
          const float v = row < 255 ? acc[mi][0][i] : 0.f;
          if (j == 0) ((u16*)(ws + A_KC))[((size_t)b * 256 + row) * 64 + d] = f2bf(v);
          else ((u16*)(ws + A_VCT))[((size_t)b * 64 + d) * 256 + row] = f2bf(v);
        }
    }
  }
}

constexpr int SM_K = 0;
constexpr int SM_V = 16384;
constexpr int SM_KB = 33792;
constexpr int SM_IMP = 34304;
constexpr int SM_SEL = 99840;
constexpr int SM_ITEM = 100352;
constexpr int SM_YP = 100608;

struct AttnSt { f32x16 o0, o1; float m, l; };
DI void attn_init(AttnSt& st) { st.o0 = zero16(); st.o1 = zero16(); st.m = -1e30f; st.l = 0.f; }

struct KVStage { u32x4 k, v; float kb; };
template <bool BIAS, bool LOADV>
DI void kv_load(KVStage& s, const u16* Kg, long ldk, const u16* Vt, long ldv, const float* kb, int key0, int tid) {
  const unsigned ch = (tid & 7) * 8, r0 = tid >> 3;
  const unsigned lk = (unsigned)ldk, lv = (unsigned)ldv;
  s.k = *(const u32x4*)(Kg + ((key0 + r0) * lk + ch));
  if (LOADV) s.v = *(const u32x4*)(Vt + (r0 * lv + key0 + ch));
  if (BIAS) { if (tid < 64) s.kb = kb[key0 + tid] * LOG2E; }
}
template <bool BIAS, bool LOADV>
DI void kv_store(const KVStage& s, char* smem, int buf, int tid) {
  const int r0 = tid >> 3, chn = tid & 7;
  const int sw = ((chn ^ ((r0 >> 1) & 7)) << 4);
  *(u32x4*)(smem + SM_K + buf * 8192 + r0 * 128 + sw) = s.k;
  if (LOADV) {
    char* vp = smem + SM_V + buf * 8704 + r0 * 136 + chn * 16;
    *(u32x2*)(vp) = s.v.xy;
    *(u32x2*)(vp + 8) = s.v.zw;
  }
  if (BIAS) { if (tid < 64) ((float*)(smem + SM_KB + buf * 256))[tid] = s.kb; }
}
DI void st_compute(f32x16 (&sacc)[2], const bf16x8 (&qf)[4], const char* kbuf, int lane) {
  const int r = lane & 31, h = lane >> 5, swz = (r >> 1) & 7;
#pragma unroll
  for (int u = 0; u < 2; ++u) {
    sacc[u] = zero16();
#pragma unroll
    for (int s = 0; s < 4; ++s) {
      const bf16x8 kf = *(const bf16x8*)(kbuf + (32 * u + r) * 128 + (((2 * s + h) ^ swz) << 4));
      sacc[u] = mfma32(kf, qf[s], sacc[u]);
    }
  }
}
template <int MODE>
DI bool key_ok(int key, int tq, int W, u64 selm, int kt) {
  if (MODE == 0) return key <= tq;
  if (MODE == 1) return key <= tq && key > tq - W;
  if (MODE == 2) return ((selm >> kt) & 1ull) && key <= tq;
  return 16 * key + 31 <= tq;
}
template <int MODE, bool BIAS>
DI void attn_loop(AttnSt& st, const bf16x8 (&qf)[4], const u16* Kg, long ldk, const u16* Vt, long ldv, const float* kb, int kt0,
                  int kt1, int tq, int W, u64 selm, float cq2, char* smem, int tid) {
  if (kt0 >= kt1) return;
  const int lane = tid & 63, r = lane & 31, h = lane >> 5;
  const int tq_min = __builtin_amdgcn_readfirstlane(tq - r), tq_max = tq_min + 31;
  KVStage kv;
  kv_load<BIAS, true>(kv, Kg, ldk, Vt, ldv, kb, kt0 * 64, tid);
  __syncthreads();
  kv_store<BIAS, true>(kv, smem, 0, tid);
  __syncthreads();
  for (int kt = kt0; kt < kt1; ++kt) {
    const int buf = (kt - kt0) & 1;
    if (kt + 1 < kt1) kv_load<BIAS, true>(kv, Kg, ldk, Vt, ldv, kb, (kt + 1) * 64, tid);
    const int key0 = kt * 64;
    bool active;
    if (MODE == 3) active = (16 * key0 + 31 <= tq_max);
    else if (MODE == 1) active = (key0 <= tq_max) && (key0 + 63 > tq_min - W);
    else active = (key0 <= tq_max);
    if (active) {
      f32x16 sacc[2];
      st_compute(sacc, qf, smem + SM_K + buf * 8192, lane);
      const float* kbs = (const float*)(smem + SM_KB + buf * 256);
      bool full;
      if (MODE == 3) full = (16 * (key0 + 63) + 31 <= tq_min);
      else if (MODE == 1) full = (key0 + 63 <= tq_min) && (key0 > tq_max - W);
      else full = (key0 + 63 <= tq_min);
      float alpha, rs = 0.f;
      if (full) {
        const bool lsel = (MODE == 2) ? (((selm >> kt) & 1ull) != 0ull) : true;
        float mx = -3e38f;
#pragma unroll
        for (int u = 0; u < 2; ++u)
#pragma unroll
          for (int g4 = 0; g4 < 4; ++g4) {
            f32x4 kb4 = {0.f, 0.f, 0.f, 0.f};
            if (BIAS) kb4 = *(const f32x4*)(kbs + 32 * u + 8 * g4 + 4 * h);
#pragma unroll
            for (int e2 = 0; e2 < 4; ++e2) {
              const int i = 4 * g4 + e2;
              if (BIAS) sacc[u][i] = __builtin_fmaf(sacc[u][i], SC2, -(e2 == 0 ? kb4.x : e2 == 1 ? kb4.y : e2 == 2 ? kb4.z : kb4.w));
              mx = fmaxf(mx, sacc[u][i]);
            }
          }
        if (!BIAS) mx *= SC2;
        if (MODE == 2) mx = lsel ? mx : -1e30f;
        mx = fmaxf(mx, __shfl_xor(mx, 32));
        const float mnew = fmaxf(st.m, mx);
        alpha = __builtin_amdgcn_exp2f(st.m - mnew);
        st.m = mnew;
#pragma unroll
        for (int u = 0; u < 2; ++u)
#pragma unroll
          for (int i = 0; i < 16; ++i) {
            float pv = BIAS ? __builtin_amdgcn_exp2f(sacc[u][i] - mnew) : __builtin_amdgcn_exp2f(__builtin_fmaf(sacc[u][i], SC2, -mnew));
            if (MODE == 2) pv = lsel ? pv : 0.f;
            rs += pv;
            sacc[u][i] = pv;
          }
      } else {
        float mx = -1e30f;
#pragma unroll
        for (int u = 0; u < 2; ++u)
#pragma unroll
          for (int g4 = 0; g4 < 4; ++g4) {
            f32x4 kb4 = {0.f, 0.f, 0.f, 0.f};
            if (BIAS) kb4 = *(const f32x4*)(kbs + 32 * u + 8 * g4 + 4 * h);
#pragma unroll
            for (int e2 = 0; e2 < 4; ++e2) {
              const int i = 4 * g4 + e2;
              const int key = key0 + 32 * u + 8 * g4 + 4 * h + e2;
              float s2 = sacc[u][i] * SC2;
              if (BIAS) s2 -= (e2 == 0 ? kb4.x : e2 == 1 ? kb4.y : e2 == 2 ? kb4.z : kb4.w);
              s2 = key_ok<MODE>(key, tq, W, selm, kt) ? s2 : -1e30f;
              sacc[u][i] = s2;
              mx = fmaxf(mx, s2);
            }
          }
        mx = fmaxf(mx, __shfl_xor(mx, 32));
        const float mnew = fmaxf(st.m, mx);
        alpha = __builtin_amdgcn_exp2f(st.m - mnew);
        st.m = mnew;
#pragma unroll
        for (int u = 0; u < 2; ++u)
#pragma unroll
          for (int i = 0; i < 16; ++i) {
            const float s2 = sacc[u][i];
            const float pv = (s2 <= -1e29f) ? 0.f : __builtin_amdgcn_exp2f(s2 - mnew);
            rs += pv;
            sacc[u][i] = pv;
          }
      }
      st.l = st.l * alpha + rs;
#pragma unroll
      for (int i = 0; i < 16; ++i) { st.o0[i] *= alpha; st.o1[i] *= alpha; }
      const char* vbuf = smem + SM_V + buf * 8704;
#pragma unroll
      for (int u = 0; u < 2; ++u)
#pragma unroll
        for (int s2i = 0; s2i < 2; ++s2i) {
          unsigned pk[4];
#pragma unroll
          for (int j = 0; j < 4; ++j) pk[j] = pack2(sacc[u][8 * s2i + 2 * j], sacc[u][8 * s2i + 2 * j + 1]);
          const u32x4 pk4 = {pk[0], pk[1], pk[2], pk[3]};
          const bf16x8 pf = __builtin_bit_cast(bf16x8, pk4);
          const int koff = (32 * u + 16 * s2i + 4 * h) * 2;
          {
            const char* vp = vbuf + r * 136 + koff;
            const u32x2 lo = *(const u32x2*)vp, hi = *(const u32x2*)(vp + 16);
            const u32x4 v4 = {lo.x, lo.y, hi.x, hi.y};
            const bf16x8 vf = __builtin_bit_cast(bf16x8, v4);
            st.o0 = mfma32(vf, pf, st.o0);
          }
          {
            const char* vp = vbuf + (32 + r) * 136 + koff;
            const u32x2 lo = *(const u32x2*)vp, hi = *(const u32x2*)(vp + 16);
            const u32x4 v4 = {lo.x, lo.y, hi.x, hi.y};
            const bf16x8 vf = __builtin_bit_cast(bf16x8, v4);
            st.o1 = mfma32(vf, pf, st.o1);
          }
        }
    }
    if (kt + 1 < kt1) kv_store<BIAS, true>(kv, smem, buf ^ 1, tid);
    __syncthreads();
  }
}
DI void load_q(bf16x8 (&qf)[4], const u16* qrow, int lane) {
  const int h = lane >> 5;
#pragma unroll
  for (int s = 0; s < 4; ++s) qf[s] = *(const bf16x8*)(qrow + 16 * s + 8 * h);
}

DI void nsa_item(const Params& p, int b, int qt, char* smem, int tid) {
  char* ws = p.ws;
  const int lane = tid & 63, wave = tid >> 6, head = wave & 3, qh = wave >> 2, r = lane & 31, h = lane >> 5;
  const int q0 = qt * 64, tq = q0 + 32 * qh + r, ql = 32 * qh + r;
  const size_t row = (size_t)b * S + tq;
  bf16x8 qf[4];
  load_q(qf, (const u16*)(ws + A_QNSA) + row * 256 + head * 64, lane);
  float* imp = (float*)(smem + SM_IMP);
  u64* selp = (u64*)(smem + SM_SEL);
  __syncthreads();
  for (int i = tid; i < 4 * 64 * 64; i += 512) imp[i] = 0.f;
  const float* gl = (const float*)(ws + A_GNSA) + row * 12 + head * 3;
  const float g0 = sigmoidf_(gl[0]), g1 = sigmoidf_(gl[1]), g2 = sigmoidf_(gl[2]);
  unsigned* yp = (unsigned*)(smem + SM_YP) + wave * 16 * 64 + lane;
  const u16* KC = (const u16*)(ws + A_KC) + (size_t)b * 256 * 64;
  const u16* VCT = (const u16*)(ws + A_VCT) + (size_t)b * 64 * 256;
  const int ktc = ((q0 + 32) >> 10) + 1;
  AttnSt st;
  attn_init(st);
  attn_loop<3, false>(st, qf, KC, 64, VCT, 256, nullptr, 0, ktc, tq, 0, 0ull, 0.f, smem, tid);
  {
    float lt = st.l + __shfl_xor(st.l, 32);
    const float inv = lt > 0.f ? 1.f / lt : 0.f;
    const float gs = g0 * inv;
#pragma unroll
    for (int i = 0; i < 8; ++i) {
      yp[i * 64] = pack2(st.o0[2 * i] * gs, st.o0[2 * i + 1] * gs);
      yp[(8 + i) * 64] = pack2(st.o1[2 * i] * gs, st.o1[2 * i + 1] * gs);
    }
    for (int kt = 0; kt < ktc; ++kt) {
      KVStage kv;
      kv_load<false, false>(kv, KC, 64, VCT, 256, nullptr, kt * 64, tid);
      __syncthreads();
      kv_store<false, false>(kv, smem, 0, tid);
      __syncthreads();
      f32x16 sacc[2];
      st_compute(sacc, qf, smem + SM_K, lane);
#pragma unroll
      for (int u = 0; u < 2; ++u)
#pragma unroll
        for (int g4 = 0; g4 < 4; ++g4) {
          float pv[4];
#pragma unroll
          for (int e = 0; e < 4; ++e) {
            const int key = kt * 64 + 32 * u + 8 * g4 + 4 * h + e;
            const float s2 = sacc[u][4 * g4 + e] * SC2;
            pv[e] = (16 * key + 31 <= tq) ? __builtin_amdgcn_exp2f(s2 - st.m) * inv : 0.f;
          }
          const int j = kt * 16 + 8 * u + 2 * g4 + h;
          atomicAdd(&imp[(head * 64 + ql) * 64 + j], pv[0] + pv[1] + pv[2] + 0.5f * pv[3]);
          if (j + 1 < 64) atomicAdd(&imp[(head * 64 + ql) * 64 + j + 1], 0.5f * pv[3]);
        }
    }
  }
  __syncthreads();
  for (int qi = 0; qi < 8; ++qi) {
    const int q = wave * 8 + qi, t = q0 + q, cur = t >> 6, j = lane;
    const float v = (imp[q * 64 + j] + imp[(64 + q) * 64 + j]) + (imp[(128 + q) * 64 + j] + imp[(192 + q) * 64 + j]);
    const float val = (j == cur || j == 0) ? 1e4f : (j <= cur ? v : -1.f);
    int rank = 0;
#pragma unroll
    for (int jj = 0; jj < 64; ++jj) {
      const float o = __int_as_float(__builtin_amdgcn_readlane(__float_as_int(val), jj));
      rank += (o > val || (o == val && jj < j)) ? 1 : 0;
    }
    const u64 mask = __ballot(rank < 16);
    if (lane == 0) selp[q] = mask;
  }
  __syncthreads();
  const u64 selm = selp[ql];
  attn_init(st);
  attn_loop<2, false>(st, qf, (const u16*)(ws + A_KSEL) + (size_t)b * S * 64, 64, (const u16*)(ws + A_VSELT) + (size_t)b * 64 * S, S,
                      nullptr, 0, ((q0 + 63) >> 6) + 1, tq, 0, selm, 0.f, smem, tid);
  {
    float lt = st.l + __shfl_xor(st.l, 32);
    const float gs = lt > 0.f ? g1 / lt : 0.f;
#pragma unroll
    for (int i = 0; i < 8; ++i) {
      const unsigned a = yp[i * 64], bq = yp[(8 + i) * 64];
      yp[i * 64] = pack2(__uint_as_float(a << 16) + st.o0[2 * i] * gs, __uint_as_float(a & 0xffff0000u) + st.o0[2 * i + 1] * gs);
      yp[(8 + i) * 64] = pack2(__uint_as_float(bq << 16) + st.o1[2 * i] * gs, __uint_as_float(bq & 0xffff0000u) + st.o1[2 * i + 1] * gs);
    }
  }
  attn_init(st);
  {
    const int lo = q0 - 511;
    attn_loop<1, false>(st, qf, (const u16*)(ws + A_KWIN) + (size_t)b * S * 64, 64, (const u16*)(ws + A_VWINT) + (size_t)b * 64 * S, S,
                        nullptr, (lo > 0 ? lo : 0) >> 6, ((q0 + 63) >> 6) + 1, tq, 512, 0ull, 0.f, smem, tid);
    float lt = st.l + __shfl_xor(st.l, 32);
    const float gs = lt > 0.f ? g2 / lt : 0.f;
    u16* ya = (u16*)(ws + A_YA) + row * 256 + head * 64;
#pragma unroll
    for (int g4 = 0; g4 < 4; ++g4) {
      u32x2 o;
      unsigned a = yp[(2 * g4) * 64], bq = yp[(2 * g4 + 1) * 64];
      o.x = pack2(__uint_as_float(a << 16) + st.o0[4 * g4] * gs, __uint_as_float(a & 0xffff0000u) + st.o0[4 * g4 + 1] * gs);
      o.y = pack2(__uint_as_float(bq << 16) + st.o0[4 * g4 + 2] * gs, __uint_as_float(bq & 0xffff0000u) + st.o0[4 * g4 + 3] * gs);
      *(u32x2*)(ya + 8 * g4 + 4 * h) = o;
      a = yp[(8 + 2 * g4) * 64]; bq = yp[(8 + 2 * g4 + 1) * 64];
      o.x = pack2(__uint_as_float(a << 16) + st.o1[4 * g4] * gs, __uint_as_float(a & 0xffff0000u) + st.o1[4 * g4 + 1] * gs);
      o.y = pack2(__uint_as_float(bq << 16) + st.o1[4 * g4 + 2] * gs, __uint_as_float(bq & 0xffff0000u) + st.o1[4 * g4 + 3] * gs);
      *(u32x2*)(ya + 32 + 8 * g4 + 4 * h) = o;
    }
  }
}

DI void fox_item(const Params& p, int b, int hd, int qb, char* smem, int tid) {
  char* ws = p.ws;
  const int lane = tid & 63, wave = tid >> 6, r = lane & 31, h = lane >> 5;
  const int tq = qb * 256 + wave * 32 + r;
  const size_t row = (size_t)b * S + tq;
  bf16x8 qf[4];
  load_q(qf, (const u16*)(ws + A_FQ) + row * 384 + hd * 64, lane);
  const float* cum = (const float*)(ws + A_CUM) + (size_t)(b * 6 + hd) * S;
  const float cq2 = cum[tq] * LOG2E;
  AttnSt st;
  attn_init(st);
  attn_loop<0, true>(st, qf, (const u16*)(ws + A_FK) + (size_t)b * S * 384 + hd * 64, 384,
                     (const u16*)(ws + A_FVT) + (size_t)(b * 6 + hd) * 64 * S, S, cum, 0, 4 * qb + 4, tq, 0, 0ull, cq2, smem, tid);
  const float lt = st.l + __shfl_xor(st.l, 32);
  const float inv = lt > 0.f ? 1.f / lt : 0.f;
  u16* yc = (u16*)(ws + A_YC) + row * 384 + hd * 64;
#pragma unroll
  for (int g4 = 0; g4 < 4; ++g4) {
    uint2 o;
    o.x = pack2(st.o0[4 * g4] * inv, st.o0[4 * g4 + 1] * inv); o.y = pack2(st.o0[4 * g4 + 2] * inv, st.o0[4 * g4 + 3] * inv);
    *(uint2*)(yc + 8 * g4 + 4 * h) = o;
    o.x = pack2(st.o1[4 * g4] * inv, st.o1[4 * g4 + 1] * inv); o.y = pack2(st.o1[4 * g4 + 2] * inv, st.o1[4 * g4 + 3] * inv);
    *(uint2*)(yc + 32 + 8 * g4 + 4 * h) = o;
  }
}

DI void dil_item(const Params& p, int b, int hh, int res, int qblk, char* smem, int tid) {
  char* ws = p.ws;
  const int lane = tid & 63, wave = tid >> 6, r = lane & 31, h = lane >> 5;
  const int g = hh >> 1, dl = 2 * g, L = S >> dl;
  const int tq = qblk * 256 + wave * 32 + r;
  const size_t prow = (size_t)b * S + (size_t)res * L + tq;
  bf16x8 qf[4];
  load_q(qf, (const u16*)(ws + A_DQ) + prow * 384 + hh * 64, lane);
  AttnSt st;
  attn_init(st);
  const int lo = qblk * 256 - 128;
  attn_loop<1, false>(st, qf, (const u16*)(ws + A_DK) + ((size_t)b * S + (size_t)res * L) * 384 + hh * 64, 384,
                      (const u16*)(ws + A_DVT) + (size_t)(b * 6 + hh) * 64 * S + (size_t)res * L, S, nullptr, (lo > 0 ? lo : 0) >> 6,
                      4 * qblk + 4, tq, 129, 0ull, 0.f, smem, tid);
  const float lt = st.l + __shfl_xor(st.l, 32);
  const float inv = lt > 0.f ? 1.f / lt : 0.f;
  const int tnat = (tq << dl) + res;
  const size_t nrow = (size_t)b * S + tnat;
  float* dp = (float*)(ws + A_DILP) + ((size_t)g * T + nrow) * 128 + (hh & 1) * 64;
#pragma unroll
  for (int g4 = 0; g4 < 4; ++g4) {
    *(float4*)(dp + 8 * g4 + 4 * h) = make_float4(st.o0[4 * g4] * inv, st.o0[4 * g4 + 1] * inv, st.o0[4 * g4 + 2] * inv, st.o0[4 * g4 + 3] * inv);
    *(float4*)(dp + 32 + 8 * g4 + 4 * h) = make_float4(st.o1[4 * g4] * inv, st.o1[4 * g4 + 1] * inv, st.o1[4 * g4 + 2] * inv, st.o1[4 * g4 + 3] * inv);
  }
  if (h == 0) ((float*)(ws + A_DILL))[((size_t)g * T + nrow) * 2 + (hh & 1)] = st.m + __builtin_amdgcn_logf(lt);
}

DI void cmpmlp_item(const Params& p, int l, int item, char* smem, int tid) {
  const int lane = tid & 63, wave = tid >> 6, wm = wave >> 2, wn = wave & 3, h_ = lane >> 5, c_ = lane & 31;
  char* ws = p.ws;
  const int b = item >> 1, j = item & 1;
  const u16* A = (const u16*)(ws + (j ? A_VCMP : A_KCMP)) + (size_t)b * S * 64;
  const u16* W = (const u16*)(ws + OFF_WC1) + (size_t)(l * 2 + j) * 128 * 2048;
  const float* peb = (const float*)(ws + OFF_PEB) + (l * 2 + j) * 128;
  f32x16 acc[4][1];
  zero_acc<4, 1>(acc);
  gemm_first<4, 1>(A, 1024, W, 2048, smem, tid);
  gemm_k<4, 1>(acc, A, 1024, W, 2048, 32, smem, tid, false, A, 1024, W, 2048);
  u16* hc = (u16*)(ws + A_HIDC) + (size_t)(b * 2 + j) * 256 * 128;
  {
    const int h = launder_i(h_), c = launder_i(c_);
    const int col = wn * 32 + c;
    const float pb = peb[col];
#pragma unroll
    for (int mi = 0; mi < 4; ++mi)
#pragma unroll
      for (int i = 0; i < 16; ++i) {
        const int row = wm * 128 + mi * 32 + crow(i, h);
        hc[(size_t)row * 128 + col] = f2bf(siluf_(acc[mi][0][i] + pb));
      }
  }
  asm volatile("s_waitcnt vmcnt(0)" ::: "memory");
  __syncthreads();
  const u16* W2 = (const u16*)(ws + OFF_WC2) + (size_t)(l * 2 + j) * 128 * 128;
  zero_acc<4, 1>(acc);
  gemm_first<4, 1>(hc, 128, W2, 128, smem, tid);
  gemm_k<4, 1>(acc, hc, 128, W2, 128, 2, smem, tid, false, hc, 128, W2, 128);
  const int h = launder_i(h_), c = launder_i(c_);
  if (wn < 2) {
    const int d = wn * 32 + c;
#pragma unroll
    for (int mi = 0; mi < 4; ++mi)
#pragma unroll
      for (int i = 0; i < 16; ++i) {
        const int row = wm * 128 + mi * 32 + crow(i, h);
        const float v = row < 255 ? acc[mi][0][i] : 0.f;
        if (j == 0) ((u16*)(ws + A_KC))[((size_t)b * 256 + row) * 64 + d] = f2bf(v);
        else ((u16*)(ws + A_VCT))[((size_t)b * 64 + d) * 256 + row] = f2bf(v);
      }
  }
}
DI void cumsum_item(const Params& p, int item, int tid) {
  const int lane = tid & 63, wave = tid >> 6;
  char* ws = p.ws;
  const int wi = item * 8 + wave;
  const int b = wi / 6, hd = wi % 6;
  const float* fl = (const float*)(ws + A_FLOG) + (size_t)b * S * 6 + hd;
  float* cum = (float*)(ws + A_CUM) + (size_t)(b * 6 + hd) * S;
  float ssum = 0.f;
  for (int k = 0; k < 64; ++k) ssum += fl[(size_t)(lane * 64 + k) * 6];
  float incl = ssum;
  for (int o = 1; o < 64; o <<= 1) { const float v = __shfl_up(incl, o); if (lane >= o) incl += v; }
  float run = incl - ssum;
  for (int k = 0; k < 64; ++k) { run += fl[(size_t)(lane * 64 + k) * 6]; cum[lane * 64 + k] = run; }
}
DI void q_publish(unsigned* cnt, int tid) {
  asm volatile("s_waitcnt vmcnt(0)" ::: "memory");
  __syncthreads();
  if (tid == 0) {
    __builtin_amdgcn_fence(__ATOMIC_RELEASE, "agent");
    asm volatile("s_waitcnt vmcnt(0)" ::: "memory");
    __hip_atomic_fetch_add(cnt, 1u, __ATOMIC_RELAXED, __HIP_MEMORY_SCOPE_AGENT);
  }
}
DI void q_wait(unsigned* cnt, unsigned n, int tid) {
  if (tid == 0) {
    while (__hip_atomic_load(cnt, __ATOMIC_RELAXED, __HIP_MEMORY_SCOPE_AGENT) < n) __builtin_amdgcn_s_sleep(4);
    __builtin_amdgcn_fence(__ATOMIC_ACQUIRE, "agent");
    asm volatile("s_waitcnt vmcnt(0)" ::: "memory");
  }
  __syncthreads();
}
constexpr int Q_CMP = 16, Q_CUM = 6, Q_DIL = 768, Q_PRE = Q_CMP + Q_CUM + Q_DIL;
constexpr int ATT_MAIN = 16 * 80;
constexpr int ATT_TOTAL = Q_PRE + ATT_MAIN;
DI void attn_phase(const Params& p, int l, char* smem, int tid0) {
  unsigned* ctr = (unsigned*)(p.ws + OFF_CTR) + l;
  unsigned* cmp_done = (unsigned*)(p.ws + OFF_CTR) + 8 + l;
  unsigned* cum_done = (unsigned*)(p.ws + OFF_CTR) + 12 + l;
  int* ip = (int*)(smem + SM_ITEM);
  bool got_cmp = false, got_cum = false;
  for (;;) {
    const int tid = launder_i(tid0);
    __syncthreads();
    if (tid == 0) *ip = (int)atomicAdd(ctr, 1u);
    __syncthreads();
    const int idx = *ip;
    if (idx >= ATT_TOTAL) break;
    if (idx < Q_CMP) {
      cmpmlp_item(p, l, idx, smem, tid);
      q_publish(cmp_done, tid);
    } else if (idx < Q_CMP + Q_CUM) {
      cumsum_item(p, idx - Q_CMP, tid);
      q_publish(cum_done, tid);
    } else if (idx < Q_PRE) {
      const int e = idx - Q_CMP - Q_CUM;
      const int bh = e >> 4, sub = e & 15;
      const int b = bh / 6, hh = bh % 6, g = hh >> 1;
      const int nblk = 16 >> (2 * g);
      dil_item(p, b, hh, sub / nblk, sub % nblk, smem, tid);
    } else {
      const int m = idx - Q_PRE;
      const int k = 15 - m / 80, rr = m % 80;
      if (rr < 48) {
        if (!got_cum) { q_wait(cum_done, Q_CUM, tid); got_cum = true; }
        fox_item(p, rr / 6, rr % 6, k, smem, tid);
      } else {
        if (!got_cmp) { q_wait(cmp_done, Q_CMP, tid); got_cmp = true; }
        const int e = rr - 48;
        nsa_item(p, e & 7, 4 * k + 3 - (e >> 3), smem, tid);
      }
    }
  }
}

DI void dilcomb_phase(const Params& p, int tid) {
  char* ws = p.ws;
  const float* dp = (const float*)(ws + A_DILP);
  const float* dlse = (const float*)(ws + A_DILL);
  u16* yb = (u16*)(ws + A_YB);
  for (size_t idx = (size_t)blockIdx.x * 512 + tid; idx < (size_t)T * 32; idx += (size_t)gridDim.x * 512) {
    const size_t row = idx >> 5;
    const int c4 = (int)(idx & 31), hs = c4 >> 4;
    const float l0 = dlse[((size_t)0 * T + row) * 2 + hs], l1 = dlse[((size_t)1 * T + row) * 2 + hs], l2 = dlse[((size_t)2 * T + row) * 2 + hs];
    const float mx = fmaxf(l0, fmaxf(l1, l2));
    float w0 = __builtin_amdgcn_exp2f(l0 - mx), w1 = __builtin_amdgcn_exp2f(l1 - mx), w2 = __builtin_amdgcn_exp2f(l2 - mx);
    const float inv = 1.f / (w0 + w1 + w2);
    w0 *= inv; w1 *= inv; w2 *= inv;
    const float4 a = *(const float4*)(dp + ((size_t)0 * T + row) * 128 + c4 * 4);
    const float4 bq = *(const float4*)(dp + ((size_t)1 * T + row) * 128 + c4 * 4);
    const float4 cq = *(const float4*)(dp + ((size_t)2 * T + row) * 128 + c4 * 4);
    uint2 o;
    o.x = pack2(w0 * a.x + w1 * bq.x + w2 * cq.x, w0 * a.y + w1 * bq.y + w2 * cq.y);
    o.y = pack2(w0 * a.z + w1 * bq.z + w2 * cq.z, w0 * a.w + w1 * bq.w + w2 * cq.w);
    *(uint2*)(yb + row * 128 + c4 * 4) = o;
  }
}

DI void merge_phase(const Params& p, int l, char* smem, int tid) {
  char* ws = p.ws;
  const u16* N = (const u16*)(ws + OFF_NBUF);
  const u16* WG = (const u16*)(ws + OFF_WMIX + (size_t)l * SZ_WMIX) + (size_t)3072 * 1024;
  u16* mg = (u16*)(ws + A_MERGED);
  int mt, nt, mt2 = 0, nt2 = 0;
  bool have = tile_coords(0, 8, 4, 128 * 8, mt, nt);
  if (have) gemm_first<4, 1>(N + (size_t)mt * 256 * 1024, 1024, WG + (size_t)nt * 128 * 1024, 1024, smem, tid);
  for (int it = 0; have; ++it, mt = mt2, nt = nt2) {
    const bool have2 = tile_coords(it + 1, 8, 4, 128 * 8, mt2, nt2);
    if (!have2) { mt2 = mt; nt2 = nt; }
    have = have2;
    f32x4 macc[8][2];
    zero_acc16<2>(macc);
#pragma unroll 1
    for (int br = 0; br < 3; ++br) {
      const u16* Y = br == 0 ? (const u16*)(ws + A_YA) : br == 1 ? (const u16*)(ws + A_YB) : (const u16*)(ws + A_YC);
      const int KB = br == 0 ? 256 : br == 1 ? 128 : 384;
      const u16* WB = br == 0 ? (const u16*)(ws + OFF_WBRA) + (size_t)l * 1024 * 256
                    : br == 1 ? (const u16*)(ws + OFF_WBRB) + (size_t)l * 1024 * 128
                              : (const u16*)(ws + OFF_WBRC) + (size_t)l * 1024 * 384;
      const u16* Ay = Y + (size_t)mt * 256 * KB;
      const u16* By = WB + (size_t)nt * 128 * KB;
      f32x4 acc[8][2];
      zero_acc16<2>(acc);
      gemm_k16<2>(acc, N + (size_t)mt * 256 * 1024, 1024, WG + ((size_t)br * 1024 + nt * 128) * 1024, 1024, 16, smem, tid, true, Ay, KB, By, KB);
      unsigned sg[8][2][2];
#pragma unroll
      for (int a = 0; a < 8; ++a)
#pragma unroll
        for (int bb = 0; bb < 2; ++bb) {
          sg[a][bb][0] = pack2(sigmoidf_(acc[a][bb].x), sigmoidf_(acc[a][bb].y));
          sg[a][bb][1] = pack2(sigmoidf_(acc[a][bb].z), sigmoidf_(acc[a][bb].w));
        }
      zero_acc16<2>(acc);
      const bool last = (br == 2);
      const int mtn = last ? mt2 : mt, ntn = last ? nt2 : nt, brn = last ? 0 : br + 1;
      gemm_k16<2>(acc, Ay, KB, By, KB, KB / 64, smem, tid, last ? have2 : true, N + (size_t)mtn * 256 * 1024, 1024,
                  WG + ((size_t)brn * 1024 + ntn * 128) * 1024, 1024);
#pragma unroll
      for (int a = 0; a < 8; ++a)
#pragma unroll
        for (int bb = 0; bb < 2; ++bb) {
          macc[a][bb].x += __uint_as_float(sg[a][bb][0] << 16) * acc[a][bb].x;
          macc[a][bb].y += __uint_as_float(sg[a][bb][0] & 0xffff0000u) * acc[a][bb].y;
          macc[a][bb].z += __uint_as_float(sg[a][bb][1] << 16) * acc[a][bb].z;
          macc[a][bb].w += __uint_as_float(sg[a][bb][1] & 0xffff0000u) * acc[a][bb].w;
        }
    }
    const int lane = tid & 63, wave = tid >> 6, wm = wave >> 2, wn = wave & 3, q = lane >> 4, c = lane & 15;
    const unsigned ebase = (unsigned)(mt * 256 + wm * 128 + 4 * q) * 1024u + (unsigned)(nt * 128 + wn * 32 + c);
#pragma unroll
    for (int mb = 0; mb < 8; ++mb)
#pragma unroll
      for (int nb = 0; nb < 2; ++nb) {
        mg[ebase + (unsigned)(mb * 16 + 0) * 1024u + (unsigned)(nb * 16)] = f2bf(macc[mb][nb].x);
        mg[ebase + (unsigned)(mb * 16 + 1) * 1024u + (unsigned)(nb * 16)] = f2bf(macc[mb][nb].y);
        mg[ebase + (unsigned)(mb * 16 + 2) * 1024u + (unsigned)(nb * 16)] = f2bf(macc[mb][nb].z);
        mg[ebase + (unsigned)(mb * 16 + 3) * 1024u + (unsigned)(nb * 16)] = f2bf(macc[mb][nb].w);
      }
  }
}

DI void final_norm_phase(const Params& p, int tid) {
  const int lane = tid & 63, wave = tid >> 6;
  for (int r = blockIdx.x * 8 + wave; r < T; r += gridDim.x * 8) {
    f32x4* src = (f32x4*)(p.out + (size_t)r * 1024);
    f32x4 v[4];
    float ss = 0.f;
#pragma unroll
    for (int j = 0; j < 4; ++j) {
      v[j] = src[lane + 64 * j];
      ss += v[j].x * v[j].x + v[j].y * v[j].y + v[j].z * v[j].z + v[j].w * v[j].w;
    }
    for (int o = 32; o; o >>= 1) ss += __shfl_xor(ss, o);
    const float rs = rsqrtf(ss * (1.f / 1024.f) + 1e-6f);
#pragma unroll
    for (int j = 0; j < 4; ++j) {
      const float4 gg = ((const float4*)p.final_g)[lane + 64 * j];
      f32x4 o4;
      o4.x = v[j].x * rs * gg.x; o4.y = v[j].y * rs * gg.y; o4.z = v[j].z * rs * gg.z; o4.w = v[j].w * rs * gg.w;
      src[lane + 64 * j] = o4;
    }
  }
}

DI int my_tid(int wave_s) { return wave_s * 64 + (int)__builtin_amdgcn_mbcnt_hi(~0u, __builtin_amdgcn_mbcnt_lo(~0u, 0u)); }
#define XB_TMO      128
#define XB_XCNT(j)  (256  + 64 * (j))
#define XB_XSUB(j)  (1280 + 64 * (j))
#define XB_XGEN(j)  (2304 + 64 * (j))
#define XB_TOP      3328
#define XB_TOPGEN   3392
#define XB_SPIN_CAP (1u << 20)
#define LAS __attribute__((address_space(3)))
DI unsigned xb_ld(unsigned* p) { return __hip_atomic_load(p, __ATOMIC_RELAXED, __HIP_MEMORY_SCOPE_AGENT); }
DI unsigned xb_add(unsigned* p, unsigned v) { return __hip_atomic_fetch_add(p, v, __ATOMIC_RELAXED, __HIP_MEMORY_SCOPE_AGENT); }
DI unsigned xb_xcc_id() { return (unsigned)__builtin_amdgcn_s_getreg((3 << 11) | 20) & 0xFu; }
#define XB_SPIN(cond, bar) do { unsigned _sp = 0; while (cond) { \
    if ((++_sp & 255u) == 0u) { if (xb_ld(&(bar)[XB_TMO])) break; if (_sp > XB_SPIN_CAP) { atomicAdd(&(bar)[XB_TMO], 1u); break; } } } } while (0)
struct XcdBarrier { unsigned* bar; unsigned x; volatile LAS unsigned* st; };
DI XcdBarrier xcd_barrier_post(unsigned* bar, volatile LAS unsigned* st) {
  XcdBarrier b; b.bar = bar; b.x = xb_xcc_id(); b.st = st;
  if (threadIdx.x == 0) (void)xb_add(&bar[XB_XCNT(b.x)], 1u);
  return b;
}
DI void xcd_barrier_complete(unsigned* bar, unsigned x, unsigned& nloc, unsigned& nx) {
  const unsigned G = gridDim.x * gridDim.y * gridDim.z;
  unsigned sum, cnt, mine, sp = 0u;
  for (;;) {
    sum = 0u; cnt = 0u; mine = 0u;
#pragma unroll
    for (unsigned j = 0; j < 16; ++j) { const unsigned c = xb_ld(&bar[XB_XCNT(j)]); sum += c; cnt += (c > 0u) ? 1u : 0u; mine = (j == x) ? c : mine; }
    if (sum == G) break;
    __builtin_amdgcn_s_sleep(1);
    if ((++sp & 255u) == 0u) { if (xb_ld(&bar[XB_TMO])) break; if (sp > XB_SPIN_CAP) { atomicAdd(&bar[XB_TMO], 1u); break; } }
  }
  nloc = mine > 0u ? mine : 1u; nx = cnt > 0u ? cnt : 1u;
}
DI void xcd_barrier(const XcdBarrier& b) {
  asm volatile("s_waitcnt vmcnt(0)" ::: "memory");
  __syncthreads();
  if (threadIdx.x == 0) {
    unsigned* bar = b.bar;
    __builtin_amdgcn_s_waitcnt(0);
    unsigned nloc = b.st[0], nx = b.st[1];
    if (nloc == 0u) { xcd_barrier_complete(bar, b.x, nloc, nx); b.st[0] = nloc; b.st[1] = nx; }
    const unsigned old = xb_add(&bar[XB_XSUB(b.x)], 1u);
    const unsigned gen = old / nloc;
    if (old + 1u == (gen + 1u) * nloc) {
      __builtin_amdgcn_fence(__ATOMIC_RELEASE, "agent");
      asm volatile("s_waitcnt vmcnt(0)" ::: "memory");
      const unsigned og = xb_add(&bar[XB_TOP], 1u);
      const unsigned tg = og / nx;
      if (og + 1u == (tg + 1u) * nx) xb_add(&bar[XB_TOPGEN], 1u);
      else XB_SPIN(xb_ld(&bar[XB_TOPGEN]) == tg, bar);
      __builtin_amdgcn_fence(__ATOMIC_ACQUIRE, "agent");
      xb_add(&bar[XB_XGEN(b.x)], 1u);
      asm volatile("s_waitcnt vmcnt(0)" ::: "memory");
    } else {
      XB_SPIN(xb_ld(&bar[XB_XGEN(b.x)]) == gen, bar);
      __builtin_amdgcn_fence(__ATOMIC_ACQUIRE, "agent");
      asm volatile("s_waitcnt vmcnt(0)" ::: "memory");
    }
  }
  __syncthreads();
}
DI char* launder_p(char* v) { asm volatile("" : "+s"(v)); return v; }
#define PH(...) { const int tid = launder_i((int)threadIdx.x); Params q = p; q.ws = launder_p(p.ws); q.out = (float*)launder_p((char*)p.out); char* ws = q.ws; (void)ws; (void)tid; __VA_ARGS__; }

template <int l>
DI void layer_body(const Params& p, const XcdBarrier& xb, char* smem) {
    PH(norm_phase(q, (l == 0) ? q.x : q.out, l, 0, tid));
    xcd_barrier(xb);
    PH(ffn1_phase(q, l, 0, smem, tid));
    xcd_barrier(xb);
    PH(resid_gemm_phase(q, (const u16*)(ws + A_HID), DFF, (const u16*)(ws + OFF_WFFN_OUT + (size_t)(l * 2 + 0) * SZ_WFFN_OUT),
                        (l == 0) ? q.x : q.out, q.out, l, 2, 0.5f, smem, tid));
    xcd_barrier(xb);
    PH(norm_phase(q, q.out, l, 1, tid));
    xcd_barrier(xb);
    PH(inproj_phase(q, l, smem, tid));
    xcd_barrier(xb);
    PH(attn_phase(q, l, smem, tid));
    xcd_barrier(xb);
    PH(dilcomb_phase(q, tid));
    xcd_barrier(xb);
    PH(merge_phase(q, l, smem, tid));
    xcd_barrier(xb);
    PH(resid_gemm_phase(q, (const u16*)(ws + A_MERGED), 1024, (const u16*)(ws + OFF_WOUT) + (size_t)l * 1024 * 1024, q.out, q.out, l, 5,
                        1.0f, smem, tid));
    xcd_barrier(xb);
    PH(norm_phase(q, q.out, l, 2, tid));
    xcd_barrier(xb);
    PH(ffn1_phase(q, l, 1, smem, tid));
    xcd_barrier(xb);
    PH(resid_gemm_phase(q, (const u16*)(ws + A_HID), DFF, (const u16*)(ws + OFF_WFFN_OUT + (size_t)(l * 2 + 1) * SZ_WFFN_OUT), q.out, q.out,
                        l, 8, 0.5f, smem, tid));
    xcd_barrier(xb);
}

constexpr int DYN_LDS = 133376 + 16;
__global__ void __launch_bounds__(512, 2) mega(Params p) {
  cg::grid_group grid = cg::this_grid();
  extern __shared__ __attribute__((aligned(16))) char smem[];
  const int wave_s = __builtin_amdgcn_readfirstlane((int)(threadIdx.x >> 6));
  PH(for (int idx = blockIdx.x; idx < P0_TOTAL; idx += gridDim.x) phase0_item(q, idx, smem, tid));
  grid.sync();
  PH({
    const float* part = (const float*)(ws + OFF_MODPART);
    float* mod = (float*)(ws + OFF_MOD);
    for (int i = blockIdx.x * 512 + tid; i < 2 * 8 * 9216; i += gridDim.x * 512) {
      const int l = i / (8 * 9216), j = i % 9216;
      float a = q.ada_b[l * 9216 + j];
      for (int kc = 0; kc < 16; ++kc) a += part[(size_t)kc * (2 * 8 * 9216) + i];
      mod[i] = a;
    }
  });
  volatile LAS unsigned* xst = (volatile LAS unsigned*)(smem + 133376);
  if (threadIdx.x == 0) { xst[0] = 0u; xst[1] = 0u; }
  __syncthreads();
  const XcdBarrier xb = xcd_barrier_post((unsigned*)(p.ws + OFF_XBAR), xst);
  xcd_barrier(xb);
  layer_body<0>(p, xb, smem);
  layer_body<1>(p, xb, smem);
  PH(final_norm_phase(q, tid));
}

extern "C" void kernel_launch(void* const* d_in, const int* in_sizes, int n_in, void* d_out, int out_size, void* d_ws,
                              size_t ws_size, hipStream_t stream) {
  static int grid_blocks = 0;
  if (!grid_blocks) {
    int dev = 0, cus = 0, per_cu = 0;
    (void)hipGetDevice(&dev);
    (void)hipDeviceGetAttribute(&cus, hipDeviceAttributeMultiprocessorCount, dev);
    (void)hipFuncSetAttribute((const void*)mega, hipFuncAttributeMaxDynamicSharedMemorySize, DYN_LDS);
    (void)hipOccupancyMaxActiveBlocksPerMultiprocessor(&per_cu, mega, 512, DYN_LDS);
    if (per_cu > 1) per_cu = 1;
    if (per_cu < 1) per_cu = 1;
    grid_blocks = cus * per_cu;
  }
  Params p{};
  p.x = (const float*)d_in[0]; p.c = (const float*)d_in[1]; p.ada_w = (const float*)d_in[2]; p.ada_b = (const float*)d_in[3];
  p.norm_g = (const float*)d_in[4]; p.final_g = (const float*)d_in[5]; p.ffn_w_in = (const float*)d_in[6];
  p.ffn_w_out = (const float*)d_in[7]; p.mix_w_in = (const float*)d_in[8]; p.cmp_pe = (const float*)d_in[9];
  p.cmp_w1 = (const float*)d_in[10]; p.cmp_w2 = (const float*)d_in[11]; p.fox_bias = (const float*)d_in[12];
  p.br_nsa = (const float*)d_in[13]; p.br_dil = (const float*)d_in[14]; p.br_fox = (const float*)d_in[15];
  p.mix_w_out = (const float*)d_in[16];
  p.out = (float*)d_out; p.ws = (char*)d_ws;
  void* args[] = {&p};
  hipError_t e = hipLaunchCooperativeKernel((void*)mega, dim3(grid_blocks), dim3(512), args, DYN_LDS, stream);
  if (e != hipSuccess) fprintf(stderr, "cooperative launch failed: %s (grid %d)\n", hipGetErrorString(e), grid_blocks);
}
```
